# Optimizing an MI355X kernel written in HIP

```python
import jax, jax.numpy as jnp
from jax import lax
import numpy as np

D_MODEL = 1024
BATCH = 16
SEQ = 4096
DEPTH = 1
DEC_BATCH = 128
DEC_SEQ = 1
PAST_LEN = 8192
PAGE_SIZE = 128

HEAD_DIM = 64
HEADS_PER_GROUP = 4
DIL_GROUPS = ((128, 1), (512, 4), (2048, 16))
N_HEADS_A = HEADS_PER_GROUP * len(DIL_GROUPS)
D_ATTN = N_HEADS_A * HEAD_DIM
D_GMLP = 512
GMLP_GROUPS = 4
GMLP_GROUP_DIM = D_GMLP // GMLP_GROUPS
CHUNK = 128
D_FF = 2816
N_ADA = 9
EPS = 1e-6
IN_SPLITS = (D_ATTN, 2 * D_ATTN, 3 * D_ATTN, 3 * D_ATTN + D_GMLP, 3 * D_ATTN + 2 * D_GMLP,
             3 * D_ATTN + 2 * D_GMLP + D_MODEL)
D_IN = 3 * D_ATTN + 2 * D_GMLP + 2 * D_MODEL

kernel_name = "hybrid_dilated_attn_gmlp_macaron_decode"


def rms_norm(x, g):
    xf = x.astype(jnp.float32)
    r = lax.rsqrt(jnp.mean(xf * xf, axis=-1, keepdims=True) + EPS)
    return (xf * r).astype(x.dtype) * g


def layer_norm(x, g, b):
    xf = x.astype(jnp.float32)
    mu = jnp.mean(xf, axis=-1, keepdims=True)
    var = jnp.mean(jnp.square(xf - mu), axis=-1, keepdims=True)
    return ((xf - mu) * lax.rsqrt(var + EPS)).astype(x.dtype) * g + b


def swiglu(h, w_up, w_down):
    a, b = jnp.split(h @ w_up, 2, axis=-1)
    return (jax.nn.silu(a) * b) @ w_down


def dilated_attn_prompt(q, k, v, window, dil):
    B, S, H, dh = q.shape
    nk = window // dil
    span = nk * dil
    s_pad = -(-S // span) * span
    nb = s_pad // span

    def to_blocks(t):
        t = jnp.pad(t, ((0, 0), (0, s_pad - S), (0, 0), (0, 0)))
        return t.reshape(B, nb, nk, dil, H, dh).transpose(0, 3, 4, 1, 2, 5)

    def with_prev(t):
        prev = jnp.pad(t, ((0, 0), (0, 0), (0, 0), (1, 0), (0, 0), (0, 0)))[:, :, :, :-1]
        return jnp.concatenate([prev, t], axis=4)

    qb = to_blocks(q)
    k2 = with_prev(to_blocks(k))
    v2 = with_prev(to_blocks(v))
    s = jnp.einsum("brhnid,brhnjd->brhnij", qb, k2,
                   preferred_element_type=jnp.float32) * (dh ** -0.5)
    i = jnp.arange(nk)[:, None]
    j = jnp.arange(2 * nk)[None, :]
    band = (j >= i) & (j <= i + nk)
    not_before_start = (jnp.arange(nb) > 0)[:, None, None] | (j >= nk)[None]
    mask = band[None] & not_before_start
    s = jnp.where(mask, s, -jnp.inf)
    lse = jax.nn.logsumexp(s, axis=-1)
    p = jnp.exp(s - lse[..., None]).astype(v.dtype)
    o = jnp.einsum("brhnij,brhnjd->brhnid", p, v2)
    o = o.transpose(0, 3, 4, 1, 2, 5).reshape(B, s_pad, H, dh)[:, :S]
    lse = lse.transpose(0, 3, 4, 1, 2).reshape(B, s_pad, H)[:, :S]
    return o, lse


def dilated_attn_sample(q, k_all, v_all, window, dil):
    Bd, T, H, dh = q.shape
    L = k_all.shape[1] - T
    nk = window // dil
    idx = (L + jnp.arange(T))[:, None] - dil * jnp.arange(nk + 1)[None, :]
    valid = idx >= 0
    idx = jnp.maximum(idx, 0)
    kg = k_all[:, idx]
    vg = v_all[:, idx]
    s = jnp.einsum("bthd,btkhd->bthk", q, kg,
                   preferred_element_type=jnp.float32) * (dh ** -0.5)
    s = jnp.where(valid[None, :, None, :], s, -jnp.inf)
    lse = jax.nn.logsumexp(s, axis=-1)
    p = jnp.exp(s - lse[..., None]).astype(v_all.dtype)
    o = jnp.einsum("bthk,btkhd->bthd", p, vg)
    return o, lse


def token_mix(h, caches, w_in, w_ba, w_bb, w_o, v_ln_g, v_ln_b, w_s, b_s):
    B, T, _ = h.shape
    proj = h @ w_in
    q, k, v, u, vb, ga, gb = jnp.split(proj, IN_SPLITS, axis=-1)
    shp = (B, T, N_HEADS_A, HEAD_DIM)
    q, k, v = q.reshape(shp), k.reshape(shp), v.reshape(shp)

    outs, lses, kv_states = [], [], []
    for g, (win, dil) in enumerate(DIL_GROUPS):
        sl = slice(g * HEADS_PER_GROUP, (g + 1) * HEADS_PER_GROUP)
        kv_new = jnp.stack([k[:, :, sl], v[:, :, sl]], axis=2)
        if caches is None:
            kv_all = kv_new
            o, lse = dilated_attn_prompt(q[:, :, sl], k[:, :, sl], v[:, :, sl], win, dil)
        else:
            kv_all = jnp.concatenate([caches[g], kv_new], axis=1)
            o, lse = dilated_attn_sample(q[:, :, sl], kv_all[:, :, 0], kv_all[:, :, 1], win, dil)
        kv_states.append(kv_all[:, kv_all.shape[1] - min(win, kv_all.shape[1]):])
        outs.append(o)
        lses.append(lse)
    wts = jax.nn.softmax(jnp.stack(lses, axis=0), axis=0)
    attn = (jnp.stack(outs, axis=0) * wts[..., None].astype(h.dtype))
    attn = attn.transpose(1, 2, 0, 3, 4).reshape(B, T, D_ATTN)

    vn = layer_norm(vb, v_ln_g, v_ln_b)
    ws = w_s * jnp.tril(jnp.ones((CHUNK, CHUNK), w_s.dtype))
    if caches is None:
        vc = vn.reshape(B, T // CHUNK, CHUNK, GMLP_GROUPS, GMLP_GROUP_DIM)
        mixed = jnp.einsum("gij,bcjgd->bcigd", ws, vc) + b_s.T[None, None, :, :, None]
        v_state = vn[:, T - CHUNK:]
    else:
        vc = vn.reshape(B, T, GMLP_GROUPS, GMLP_GROUP_DIM)
        mixed = jnp.einsum("gij,bjgd->bigd", ws[:, :T, :T], vc) + b_s[:, :T].T[None, :, :, None]
        v_state = vn
    gm = u * mixed.reshape(B, T, D_GMLP)

    merged = jax.nn.sigmoid(ga) * (attn @ w_ba) + jax.nn.sigmoid(gb) * (gm @ w_bb)
    return merged @ w_o, (kv_states[0], kv_states[1], kv_states[2], v_state)


def decoder_layer(x, c, caches, ada_w, ada_b, norm_g, ffn1_up, ffn1_down, w_in, w_ba, w_bb, w_o,
                  v_ln_g, v_ln_b, w_s, b_s, ffn2_up, ffn2_down):
    B = c.shape[0]
    mod = (jax.nn.silu(c) @ ada_w + ada_b).reshape(B, N_ADA, D_MODEL)[:, None]

    def pre(i, t):
        return rms_norm(t, norm_g[i]) * (1 + mod[:, :, 3 * i + 1]) + mod[:, :, 3 * i]

    x = x + 0.5 * mod[:, :, 2] * swiglu(pre(0, x), ffn1_up, ffn1_down)
    y, states = token_mix(pre(1, x), caches, w_in, w_ba, w_bb, w_o, v_ln_g, v_ln_b, w_s, b_s)
    x = x + mod[:, :, 5] * y
    x = x + 0.5 * mod[:, :, 8] * swiglu(pre(2, x), ffn2_up, ffn2_down)
    return x, states


def setup_inputs(seed: int = 0) -> dict:
    key = jax.random.key(seed)
    ks = jax.random.split(key, 24)
    f32 = jnp.float32

    def nrm(k, shape, scale):
        return jax.random.normal(k, shape, f32) * scale

    lens = [min(w, PAST_LEN) for w, _ in DIL_GROUPS]
    return {
        "x_prompt": nrm(ks[0], (BATCH, SEQ, D_MODEL), 1.0),
        "x_sample": nrm(ks[1], (DEC_BATCH, DEC_SEQ, D_MODEL), 1.0),
        "c_prompt": nrm(ks[2], (BATCH, D_MODEL), 1.0),
        "c_sample": nrm(ks[3], (DEC_BATCH, D_MODEL), 1.0),
        "cache_kv_g0": nrm(ks[4], (DEPTH, DEC_BATCH, lens[0], 2, HEADS_PER_GROUP, HEAD_DIM), 1.0),
        "cache_kv_g1": nrm(ks[5], (DEPTH, DEC_BATCH, lens[1], 2, HEADS_PER_GROUP, HEAD_DIM), 1.0),
        "cache_kv_g2": nrm(ks[6], (DEPTH, DEC_BATCH, lens[2], 2, HEADS_PER_GROUP, HEAD_DIM), 1.0),
        "ada_w": nrm(ks[7], (DEPTH, D_MODEL, N_ADA * D_MODEL), 0.5 * D_MODEL ** -0.5),
        "ada_b": nrm(ks[8], (DEPTH, N_ADA * D_MODEL), 0.02),
        "norm_g": 1.0 + nrm(ks[9], (DEPTH, 3, D_MODEL), 0.02),
        "ffn1_up": nrm(ks[10], (DEPTH, D_MODEL, 2 * D_FF), D_MODEL ** -0.5),
        "ffn1_down": nrm(ks[11], (DEPTH, D_FF, D_MODEL), D_FF ** -0.5),
        "w_in": nrm(ks[12], (DEPTH, D_MODEL, D_IN), D_MODEL ** -0.5),
        "w_branch_a": nrm(ks[13], (DEPTH, D_ATTN, D_MODEL), D_ATTN ** -0.5),
        "w_branch_b": nrm(ks[14], (DEPTH, D_GMLP, D_MODEL), D_GMLP ** -0.5),
        "w_out": nrm(ks[15], (DEPTH, D_MODEL, D_MODEL), D_MODEL ** -0.5),
        "v_ln_g": 1.0 + nrm(ks[16], (DEPTH, D_GMLP), 0.02),
        "v_ln_b": nrm(ks[17], (DEPTH, D_GMLP), 0.02),
        "w_spatial": nrm(ks[18], (DEPTH, GMLP_GROUPS, CHUNK, CHUNK), CHUNK ** -0.5),
        "b_spatial": 1.0 + nrm(ks[19], (DEPTH, GMLP_GROUPS, CHUNK), 0.02),
        "ffn2_up": nrm(ks[20], (DEPTH, D_MODEL, 2 * D_FF), D_MODEL ** -0.5),
        "ffn2_down": nrm(ks[21], (DEPTH, D_FF, D_MODEL), D_FF ** -0.5),
        "final_g": 1.0 + nrm(ks[22], (D_MODEL,), 0.02),
    }


def reference(x_prompt, x_sample, c_prompt, c_sample, cache_kv_g0, cache_kv_g1, cache_kv_g2,
              ada_w, ada_b, norm_g, ffn1_up, ffn1_down, w_in, w_branch_a, w_branch_b, w_out,
              v_ln_g, v_ln_b, w_spatial, b_spatial, ffn2_up, ffn2_down, final_g):
    hp, hs = x_prompt, x_sample
    st_p, st_s = [], []
    for l in range(DEPTH):
        weights = (ada_w[l], ada_b[l], norm_g[l], ffn1_up[l], ffn1_down[l], w_in[l], w_branch_a[l],
                   w_branch_b[l], w_out[l], v_ln_g[l], v_ln_b[l], w_spatial[l], b_spatial[l],
                   ffn2_up[l], ffn2_down[l])
        hp, sp = decoder_layer(hp, c_prompt, None, *weights)
        hs, ss = decoder_layer(hs, c_sample, (cache_kv_g0[l], cache_kv_g1[l], cache_kv_g2[l]), *weights)
        st_p.append(sp)
        st_s.append(ss)
    y_prompt = rms_norm(hp, final_g)
    y_sample = rms_norm(hs, final_g)
    kv_g0_prompt = jnp.stack([s[0] for s in st_p])
    kv_g1_prompt = jnp.stack([s[1] for s in st_p])
    kv_g2_prompt = jnp.stack([s[2] for s in st_p])
    vrows_prompt = jnp.stack([s[3] for s in st_p])
    kv_g0_sample = jnp.stack([s[0] for s in st_s])
    kv_g1_sample = jnp.stack([s[1] for s in st_s])
    kv_g2_sample = jnp.stack([s[2] for s in st_s])
    vrows_sample = jnp.stack([s[3] for s in st_s])
    return (y_prompt, y_sample, kv_g0_prompt, kv_g1_prompt, kv_g2_prompt, vrows_prompt,
            kv_g0_sample, kv_g1_sample, kv_g2_sample, vrows_sample)
```

```cpp
#include <hip/hip_runtime.h>
#include <cstdio>
#include <cstdint>

#define LAS __attribute__((address_space(3)))
#define GAS __attribute__((address_space(1)))
typedef unsigned short bf16_t;
typedef short bf16x8 __attribute__((ext_vector_type(8)));
typedef short s16x4 __attribute__((ext_vector_type(4)));
typedef float f32x4 __attribute__((ext_vector_type(4)));
typedef float f32x2 __attribute__((ext_vector_type(2)));
typedef float f32x16 __attribute__((ext_vector_type(16)));
typedef unsigned u32x4 __attribute__((ext_vector_type(4)));
typedef unsigned u32x2 __attribute__((ext_vector_type(2)));
typedef GAS unsigned gu32;

#ifndef SIMPLE_GEMM
#define SIMPLE_GEMM 0
#endif

constexpr int D = 1024, NB = 16, SEQ = 4096, MP = NB * SEQ  , DB = 128  , MPAD = MP + 256;
constexpr int FF = 2816, DIN = 5376, DATT = 768, DG = 512, KAG = DATT + DG  , NADA = 9 * D;
constexpr int NMOD = NB + DB;
constexpr float EPS = 1e-6f;
constexpr size_t O_YP = 0, O_YS = 67108864, O_KV0P = 67239936, O_KV1P = 68288512, O_KV2P = 72482816, O_VRP = 89260032,
                 O_KV0S = 90308608, O_KV1S = 98697216, O_KV2S = 132251648, O_VRS = 266469376, O_END = 266534912;

__device__ __forceinline__ unsigned cvt_pk_bf16(float lo, float hi) { unsigned r; asm volatile("v_cvt_pk_bf16_f32 %0, %1, %2" : "=v"(r) : "v"(lo), "v"(hi)); return r; }
__device__ __forceinline__ float bf2f(unsigned short b) { return __uint_as_float((unsigned)b << 16); }
__device__ __forceinline__ float bflo(unsigned w) { return __uint_as_float(w << 16); }
__device__ __forceinline__ float bfhi(unsigned w) { return __uint_as_float(w & 0xffff0000u); }
__device__ __forceinline__ float fast_rcp(float x) { return __builtin_amdgcn_rcpf(x); }
__device__ __forceinline__ float sigmoidf_(float x) { return fast_rcp(1.0f + __builtin_amdgcn_exp2f(-1.44269504089f * x)); }
__device__ __forceinline__ float siluf_(float x) { return x * sigmoidf_(x); }

namespace pg8 {
#define PG8_LAS __attribute__((address_space(3)))
constexpr int BM = 256, BK = 64, HALF = 128, HTB = HALF * BK * 2  , STAGE_BYTES = 8 * HTB, NXCD = 8, WGM = 8;

__host__ __device__ __forceinline__ int lds_byte(int r, int c) { const int st = (r >> 4) * 2 + (c >> 5), rr = r & 15, cc = c & 31, ob = rr * 64 + cc * 2; return st * 1024 + (ob ^ (((ob >> 9) & 1) << 5)); }
__host__ __device__ __forceinline__ void stage_rc(int b, int& R, int& C) { const int st = b / 1024, sb = b % 1024, swz = sb ^ (((sb >> 9) & 1) << 5); R = (st >> 1) * 16 + swz / 64; C = (st & 1) * 32 + (swz % 64) / 2; }
__host__ __device__ __forceinline__ int perm32(int rho) { const int n = rho >> 4, i = rho & 15; return 8 * (i >> 2) + 4 * n + (i & 3); }

struct Unit { int pm, pn; };
struct Gemm { const bf16_t* A; const bf16_t* Bt; int M, N, K; };

struct StaticOrder {
    int nM, nN, nwg, G, c;
    __host__ __device__ void init(int M, int N, int G_, int c_) { nM = M / BM; nN = N / BM; nwg = nM * nN; G = G_; c = c_; }
    __host__ __device__ bool next(int i, Unit& u) const {
        const long L = (long)i * G + c; if (L >= nwg) return false;
        int wgid = (int)L; { const int q = nwg / NXCD, r = nwg % NXCD, xcd = wgid % NXCD, off = wgid / NXCD; wgid = (xcd < r ? xcd * (q + 1) : r * (q + 1) + (xcd - r) * q) + off; }
        const int nig = WGM * nN, gid = wgid / nig, fm = gid * WGM, gsz = (nM - fm) < WGM ? (nM - fm) : WGM;
        u.pm = fm + ((wgid % nig) % gsz); u.pn = (wgid % nig) / gsz; return true;
    }
    __device__ __forceinline__ void a_ready(const Unit&) const {}
    __device__ __forceinline__ void done(const Unit&) const {}
};


struct EpiUp {
    static constexpr bool PERM = true, AFTER_DRAIN = false; static constexpr int MID_T = 0;
    bf16_t* H;
    __device__ __forceinline__ void operator()(const f32x4 (&acc)[2][2][4][2], const Unit& u, int wr, int wc, int fr, int fq) const {
        const int row0 = u.pm * BM + wr * 64 + fr, col0 = u.pn * HALF + wc * 32 + 8 * fq;
#pragma unroll
        for (int ai = 0; ai < 2; ++ai)
#pragma unroll
            for (int m = 0; m < 4; ++m) {
                const f32x4 a0 = acc[ai][0][m][0], a1 = acc[ai][0][m][1], b0 = acc[ai][1][m][0], b1 = acc[ai][1][m][1];
                u32x4 w;
                w.x = cvt_pk_bf16(siluf_(a0[0]) * b0[0], siluf_(a0[1]) * b0[1]); w.y = cvt_pk_bf16(siluf_(a0[2]) * b0[2], siluf_(a0[3]) * b0[3]);
                w.z = cvt_pk_bf16(siluf_(a1[0]) * b1[0], siluf_(a1[1]) * b1[1]); w.w = cvt_pk_bf16(siluf_(a1[2]) * b1[2], siluf_(a1[3]) * b1[3]);
                *(u32x4*)(H + (size_t)(row0 + ai * HALF + m * 16) * FF + col0) = w;
            }
    }
};
struct EpiResid {
    static constexpr bool PERM = false, AFTER_DRAIN = false; static constexpr int MID_T = 0;
    const float* base; float* out; const float* mod; int gate_idx; float gs;
    __device__ __forceinline__ void operator()(const f32x4 (&acc)[2][2][4][2], const Unit& u, int wr, int wc, int fr, int fq) const {
        const int row0 = u.pm * BM + wr * 64 + fr, col0 = u.pn * BM + wc * 32 + 4 * fq;
        const float* gp = mod + (size_t)(u.pm >> 4) * NADA + gate_idx * D + col0;
        f32x4 gv[2][2];
#pragma unroll
        for (int bj = 0; bj < 2; ++bj)
#pragma unroll
            for (int n = 0; n < 2; ++n) gv[bj][n] = *(const f32x4*)(gp + bj * HALF + n * 16) * gs;
#pragma unroll
        for (int ai = 0; ai < 2; ++ai)
#pragma unroll
            for (int m = 0; m < 4; ++m) { const size_t off = (size_t)(row0 + ai * HALF + m * 16) * D + col0;
#pragma unroll
                for (int bj = 0; bj < 2; ++bj)
#pragma unroll
                    for (int n = 0; n < 2; ++n) { const f32x4 bs = *(const f32x4*)(base + off + bj * HALF + n * 16); *(f32x4*)(out + off + bj * HALF + n * 16) = bs + gv[bj][n] * acc[ai][bj][m][n]; } }
    }
};
struct EpiProj {
    static constexpr bool PERM = true, AFTER_DRAIN = false; static constexpr int MID_T = 0;
    bf16_t *QKV, *U, *VB, *SA, *SB; float* out;
    __device__ __forceinline__ void operator()(const f32x4 (&acc)[2][2][4][2], const Unit& u, int wr, int wc, int fr, int fq) const {
        const int pn = u.pn, row0 = u.pm * BM + wr * 64 + fr, c8 = wc * 32 + 8 * fq;
        bf16_t* dst; int ld; bool sig = false;
        if (pn < 9) { dst = QKV + pn * BM; ld = 3 * DATT; }
        else if (pn < 11) { dst = U + (pn - 9) * BM; ld = DG; }
        else if (pn < 13) { dst = VB + (pn - 11) * BM; ld = DG; }
        else if (pn < 17) { dst = SA + (pn - 13) * BM; ld = D; sig = true; }
        else { dst = SB + (pn - 17) * BM; ld = D; sig = true; }
#pragma unroll
        for (int ai = 0; ai < 2; ++ai)
#pragma unroll
            for (int m = 0; m < 4; ++m) { bf16_t* rowp = dst + (size_t)(row0 + ai * HALF + m * 16) * ld + c8;
#pragma unroll
                for (int bj = 0; bj < 2; ++bj) { f32x4 v0 = acc[ai][bj][m][0], v1 = acc[ai][bj][m][1];
                    if (sig) {
#pragma unroll
                        for (int e = 0; e < 4; ++e) { v0[e] = sigmoidf_(v0[e]); v1[e] = sigmoidf_(v1[e]); } }
                    u32x4 w; w.x = cvt_pk_bf16(v0[0], v0[1]); w.y = cvt_pk_bf16(v0[2], v0[3]); w.z = cvt_pk_bf16(v1[0], v1[1]); w.w = cvt_pk_bf16(v1[2], v1[3]);
                    *(u32x4*)(rowp + bj * HALF) = w; } }
        if (pn >= 3 && pn < 9) {
            const int g = (pn - 3) % 3, isv = (pn >= 6) ? 1 : 0, win = 128 << (2 * g), b = u.pm >> 4, t0 = (u.pm & 15) * BM;
            if (t0 + BM > SEQ - win) {
                const size_t obase = (g == 0 ? O_KV0P : (g == 1 ? O_KV1P : O_KV2P)) + (size_t)b * win * 512 + isv * 256 + c8;
#pragma unroll
                for (int ai = 0; ai < 2; ++ai)
#pragma unroll
                    for (int m = 0; m < 4; ++m) { const int i = t0 + ai * HALF + wr * 64 + m * 16 + fr - (SEQ - win);
                        if (i >= 0) { float* p = out + obase + (size_t)i * 512;
#pragma unroll
                            for (int bj = 0; bj < 2; ++bj) { *(f32x4*)(p + bj * HALF) = acc[ai][bj][m][0]; *(f32x4*)(p + bj * HALF + 4) = acc[ai][bj][m][1]; } } }
            }
        }
    }
};
struct EpiMerge {
    static constexpr bool PERM = true, AFTER_DRAIN = false; static constexpr int MID_T = DATT / 64;
    const bf16_t *SA, *SB; bf16_t* MG;
    __device__ __forceinline__ void mid(f32x4 (&acc)[2][2][4][2], const Unit& u, int wr, int wc, int fr, int fq) const {
        int row0 = u.pm * BM + wr * 64 + fr; const int col0 = u.pn * BM + wc * 32 + 8 * fq;
        asm volatile("" : "+v"(row0));
#pragma unroll
        for (int ai = 0; ai < 2; ++ai)
#pragma unroll
            for (int m = 0; m < 4; ++m) { const size_t off = (size_t)(row0 + ai * HALF + m * 16) * D + col0;
#pragma unroll
                for (int bj = 0; bj < 2; ++bj) { const u32x4 a = *(const u32x4*)(SA + off + bj * HALF), b = *(const u32x4*)(SB + off + bj * HALF);
                    f32x4 r0, r1;
                    r0[0] = bflo(a.x) * fast_rcp(bflo(b.x)); r0[1] = bfhi(a.x) * fast_rcp(bfhi(b.x)); r0[2] = bflo(a.y) * fast_rcp(bflo(b.y)); r0[3] = bfhi(a.y) * fast_rcp(bfhi(b.y));
                    r1[0] = bflo(a.z) * fast_rcp(bflo(b.z)); r1[1] = bfhi(a.z) * fast_rcp(bfhi(b.z)); r1[2] = bflo(a.w) * fast_rcp(bflo(b.w)); r1[3] = bfhi(a.w) * fast_rcp(bfhi(b.w));
                    acc[ai][bj][m][0] *= r0; acc[ai][bj][m][1] *= r1; } }
    }
    __device__ __forceinline__ void operator()(const f32x4 (&acc)[2][2][4][2], const Unit& u, int wr, int wc, int fr, int fq) const {
        const int row0 = u.pm * BM + wr * 64 + fr, col0 = u.pn * BM + wc * 32 + 8 * fq;
#pragma unroll
        for (int ai = 0; ai < 2; ++ai)
#pragma unroll
            for (int m = 0; m < 4; ++m) { const size_t off = (size_t)(row0 + ai * HALF + m * 16) * D + col0;
#pragma unroll
                for (int bj = 0; bj < 2; ++bj) { const u32x4 b = *(const u32x4*)(SB + off + bj * HALF); const f32x4 v0 = acc[ai][bj][m][0], v1 = acc[ai][bj][m][1];
                    u32x4 w; w.x = cvt_pk_bf16(v0[0] * bflo(b.x), v0[1] * bfhi(b.x)); w.y = cvt_pk_bf16(v0[2] * bflo(b.y), v0[3] * bfhi(b.y));
                    w.z = cvt_pk_bf16(v1[0] * bflo(b.z), v1[1] * bfhi(b.z)); w.w = cvt_pk_bf16(v1[2] * bflo(b.w), v1[3] * bfhi(b.w));
                    *(u32x4*)(MG + off + bj * HALF) = w; } }
    }
};

template <class Epi, class Sched>
__device__ __forceinline__ void gemm_simple(const Gemm g, const Sched& S, const Epi& E) {
    const int tid = threadIdx.x, wid = __builtin_amdgcn_readfirstlane(tid >> 6), lane = tid & 63, wr = wid >> 2, wc = wid & 3, fr = lane & 15, fq = lane >> 4;
    const int K = g.K; Unit cur;
    for (int ui = 0; S.next(ui, cur); ++ui) {
        f32x4 acc[2][2][4][2];
#pragma unroll
        for (int a = 0; a < 2; ++a)
#pragma unroll
            for (int b = 0; b < 2; ++b)
#pragma unroll
                for (int m = 0; m < 4; ++m)
#pragma unroll
                    for (int n = 0; n < 2; ++n) acc[a][b][m][n] = (f32x4){0.f, 0.f, 0.f, 0.f};
        const bf16_t* ap = g.A + (size_t)(cur.pm * BM + wr * 64 + fr) * K + 8 * fq;
        const bf16_t* bp[2];
#pragma unroll
        for (int n = 0; n < 2; ++n) bp[n] = g.Bt + (size_t)(cur.pn * BM + wc * 32 + (Epi::PERM ? perm32(16 * n + fr) : 16 * n + fr)) * K + 8 * fq;
        for (int t = 0; t < K / 32; ++t) {
            if constexpr (Epi::MID_T > 0) { if (t == 2 * Epi::MID_T) E.mid(acc, cur, wr, wc, fr, fq); }
            bf16x8 Af[2][4], Bf[2][2];
#pragma unroll
            for (int ai = 0; ai < 2; ++ai)
#pragma unroll
                for (int m = 0; m < 4; ++m) Af[ai][m] = *(const bf16x8*)(ap + (size_t)(ai * HALF + m * 16) * K + t * 32);
#pragma unroll
            for (int bj = 0; bj < 2; ++bj)
#pragma unroll
                for (int n = 0; n < 2; ++n) Bf[bj][n] = *(const bf16x8*)(bp[n] + (size_t)(bj * HALF) * K + t * 32);
#pragma unroll
            for (int ai = 0; ai < 2; ++ai)
#pragma unroll
                for (int bj = 0; bj < 2; ++bj)
#pragma unroll
                    for (int m = 0; m < 4; ++m)
#pragma unroll
                        for (int n = 0; n < 2; ++n) acc[ai][bj][m][n] = __builtin_amdgcn_mfma_f32_16x16x32_bf16(Bf[bj][n], Af[ai][m], acc[ai][bj][m][n], 0, 0, 0);
        }
        E(acc, cur, wr, wc, fr, fq);
    }
}

template <class Epi, class Sched, bool ALIGN_EPI = false, bool SP2 = false>
__device__ __forceinline__ void gemm_phase(PG8_LAS unsigned char* lds, const Gemm g, const Sched& S, const Epi& E) {
    const int tid = threadIdx.x, wid = __builtin_amdgcn_readfirstlane(tid >> 6), lane = tid & 63, wr = wid >> 2, wc = wid & 3, fr = lane & 15, fq = lane >> 4;
    const int K = g.K, nt = K / BK;
    unsigned voffA[2], voffB[2];
#pragma unroll
    for (int i = 0; i < 2; ++i) { int R, C; stage_rc(tid * 16 + i * 8192, R, C); const int Rb = Epi::PERM ? ((R & ~31) + perm32(R & 31)) : R;
        voffA[i] = (unsigned)(R * K + C) * 2u; voffB[i] = (unsigned)(Rb * K + C) * 2u; }
    const size_t kstep = (size_t)(BK * 2);
    const size_t hstep = (size_t)HALF * K * 2;
    const size_t tstep = 2 * hstep;
    const unsigned ldsw = (unsigned)wid * 1024u;
    const int aoff = lds_byte(wr * 64 + fr, fq * 8), boff = lds_byte(wc * 32 + fr, fq * 8);
#define PG8_SA(b, h) (((b) * 2 + (h)) * HTB)
#define PG8_SB(b, h) ((4 + (b) * 2 + (h)) * HTB)
#define PG8_STAGE(bufoff, gbase, voff) do { _Pragma("unroll") for (int _i = 0; _i < 2; ++_i) \
        __builtin_amdgcn_global_load_lds((const unsigned*)((const char*)(gbase) + (voff)[_i]), (PG8_LAS unsigned*)(lds + (bufoff) + ldsw + _i * 8192), 16, 0, 0); } while (0)
#define PG8_LDA(dst, b, h) do { _Pragma("unroll") for (int m = 0; m < 4; ++m) _Pragma("unroll") for (int k = 0; k < 2; ++k) dst[m][k] = *(const PG8_LAS bf16x8*)(lds + PG8_SA(b, h) + aoff + m * 2048 + k * 1024); } while (0)
#define PG8_LDB(dst, b, h) do { _Pragma("unroll") for (int n = 0; n < 2; ++n) _Pragma("unroll") for (int k = 0; k < 2; ++k) dst[n][k] = *(const PG8_LAS bf16x8*)(lds + PG8_SB(b, h) + boff + n * 2048 + k * 1024); } while (0)
#define PG8_MMA(ai, bj, At, Bt) do { __builtin_amdgcn_s_setprio(1); _Pragma("unroll") for (int m = 0; m < 4; ++m) _Pragma("unroll") for (int n = 0; n < 2; ++n) _Pragma("unroll") for (int k = 0; k < 2; ++k) \
        acc[ai][bj][m][n] = __builtin_amdgcn_mfma_f32_16x16x32_bf16(Bt[n][k], At[m][k], acc[ai][bj][m][n], 0, 0, 0); __builtin_amdgcn_s_setprio(0); } while (0)
#define PG8_WAIT_V(n) asm volatile("s_waitcnt vmcnt(" #n ")" ::: "memory")
#define PG8_WAIT_L(n) asm volatile("s_waitcnt lgkmcnt(" #n ")" ::: "memory")
#define PG8_BAR __builtin_amdgcn_s_barrier()
#define PG8_SCHED __builtin_amdgcn_sched_barrier(0)
    Unit cur, nxt; int ui = 0;
    if (!S.next(0, cur)) return;
    f32x4 acc[2][2][4][2];
#pragma unroll
    for (int a = 0; a < 2; ++a)
#pragma unroll
        for (int b = 0; b < 2; ++b)
#pragma unroll
            for (int m = 0; m < 4; ++m)
#pragma unroll
                for (int n = 0; n < 2; ++n) acc[a][b][m][n] = (f32x4){0.f, 0.f, 0.f, 0.f};
    bf16x8 At[4][2], B0[2][2], B1[2][2];
    const char* cA = (const char*)g.A + (size_t)cur.pm * tstep; const char* cB = (const char*)g.Bt + (size_t)cur.pn * tstep;
    S.a_ready(cur);
    if constexpr (SP2) {
        PG8_STAGE(PG8_SB(0, 0), cB, voffB); PG8_STAGE(PG8_SB(0, 1), cB + hstep, voffB); PG8_STAGE(PG8_SA(0, 0), cA, voffA); PG8_STAGE(PG8_SA(0, 1), cA + hstep, voffA);
        if (wr == 1) PG8_BAR;
        PG8_WAIT_V(2); PG8_BAR;
        PG8_STAGE(PG8_SB(1, 0), cB + kstep, voffB); PG8_STAGE(PG8_SA(1, 0), cA + kstep, voffA); PG8_STAGE(PG8_SB(1, 1), cB + hstep + kstep, voffB);
        PG8_WAIT_V(6); PG8_BAR;
    } else {
        PG8_STAGE(PG8_SB(0, 0), cB, voffB); PG8_STAGE(PG8_SA(0, 0), cA, voffA); PG8_STAGE(PG8_SB(0, 1), cB + hstep, voffB); PG8_STAGE(PG8_SA(0, 1), cA + hstep, voffA);
        if (wr == 1) PG8_BAR;
        PG8_WAIT_V(4); PG8_BAR;
        PG8_STAGE(PG8_SB(1, 0), cB + kstep, voffB); PG8_STAGE(PG8_SA(1, 0), cA + kstep, voffA); PG8_STAGE(PG8_SB(1, 1), cB + hstep + kstep, voffB);
        PG8_WAIT_V(6); PG8_BAR;
    }
    for (;;) {
        const bool has_next = S.next(ui + 1, nxt);
        const char* nA = has_next ? (const char*)g.A + (size_t)nxt.pm * tstep : cA; const char* nB = has_next ? (const char*)g.Bt + (size_t)nxt.pn * tstep : cB;
        for (int t = 0; t < nt; t += 2) {
            const bool last = (t == nt - 2);
            if constexpr (Epi::MID_T > 0) { if (t == Epi::MID_T) E.mid(acc, cur, wr, wc, fr, fq); }
            const char* a1 = cA + (size_t)(t + 1) * kstep;
            const char* a2 = last ? nA : cA + (size_t)(t + 2) * kstep; const char* b2 = last ? nB : cB + (size_t)(t + 2) * kstep;
            const char* a3 = a2 + kstep; const char* b3 = b2 + kstep;
            if (last && has_next) S.a_ready(nxt);
            if constexpr (SP2) {
            PG8_LDB(B0, 0, 0); PG8_LDB(B1, 0, 1); PG8_SCHED; PG8_LDA(At, 0, 0); PG8_STAGE(PG8_SA(1, 1), a1 + hstep, voffA);
            PG8_WAIT_V(8); PG8_WAIT_L(0); PG8_BAR; PG8_MMA(0, 0, At, B0); PG8_MMA(0, 1, At, B1); PG8_BAR; PG8_SCHED;
            PG8_LDA(At, 0, 1); PG8_STAGE(PG8_SB(0, 0), b2, voffB); PG8_STAGE(PG8_SB(0, 1), b2 + hstep, voffB); PG8_STAGE(PG8_SA(0, 0), a2, voffA);
            PG8_WAIT_V(8); PG8_WAIT_L(0); PG8_BAR; PG8_MMA(1, 0, At, B0); PG8_MMA(1, 1, At, B1); PG8_BAR; PG8_SCHED;
            PG8_LDB(B0, 1, 0); PG8_LDB(B1, 1, 1); PG8_SCHED; PG8_LDA(At, 1, 0); PG8_STAGE(PG8_SA(0, 1), a2 + hstep, voffA);
            PG8_WAIT_V(8); PG8_WAIT_L(0); PG8_BAR; PG8_MMA(0, 0, At, B0); PG8_MMA(0, 1, At, B1); PG8_BAR; PG8_SCHED;
            PG8_LDA(At, 1, 1); PG8_STAGE(PG8_SB(1, 0), b3, voffB); PG8_STAGE(PG8_SB(1, 1), b3 + hstep, voffB); PG8_STAGE(PG8_SA(1, 0), a3, voffA);
            PG8_WAIT_V(8); PG8_WAIT_L(0); PG8_BAR; PG8_MMA(1, 0, At, B0); PG8_MMA(1, 1, At, B1); PG8_BAR; PG8_SCHED;
            } else {
            PG8_LDB(B0, 0, 0); PG8_SCHED; PG8_LDA(At, 0, 0); PG8_STAGE(PG8_SA(1, 1), a1 + hstep, voffA);
            PG8_WAIT_L(8); PG8_BAR; PG8_WAIT_L(0); PG8_MMA(0, 0, At, B0); PG8_BAR; PG8_SCHED;
            PG8_LDB(B1, 0, 1); PG8_STAGE(PG8_SB(0, 0), b2, voffB);
            PG8_BAR; PG8_WAIT_L(0); PG8_MMA(0, 1, At, B1); PG8_BAR;
            PG8_LDA(At, 0, 1); PG8_STAGE(PG8_SA(0, 0), a2, voffA);
            PG8_BAR; PG8_WAIT_L(0); PG8_MMA(1, 0, At, B0); PG8_BAR; PG8_SCHED;
            PG8_STAGE(PG8_SB(0, 1), b2 + hstep, voffB);
            PG8_WAIT_V(6); PG8_BAR; PG8_MMA(1, 1, At, B1); PG8_BAR;
            PG8_LDB(B0, 1, 0); PG8_SCHED; PG8_LDA(At, 1, 0); PG8_STAGE(PG8_SA(0, 1), a2 + hstep, voffA);
            PG8_WAIT_L(8); PG8_BAR; PG8_WAIT_L(0); PG8_MMA(0, 0, At, B0); PG8_BAR; PG8_SCHED;
            PG8_LDB(B1, 1, 1); PG8_STAGE(PG8_SB(1, 0), b3, voffB);
            PG8_BAR; PG8_WAIT_L(0); PG8_MMA(0, 1, At, B1); PG8_BAR;
            PG8_LDA(At, 1, 1); PG8_STAGE(PG8_SA(1, 0), a3, voffA);
            PG8_BAR; PG8_WAIT_L(0); PG8_MMA(1, 0, At, B0); PG8_BAR; PG8_SCHED;
            PG8_STAGE(PG8_SB(1, 1), b3 + hstep, voffB);
            PG8_WAIT_V(6); PG8_BAR; PG8_MMA(1, 1, At, B1); PG8_BAR;
            }
        }
        if constexpr (ALIGN_EPI) { if (wr == 0) PG8_BAR; }
        if constexpr (!Epi::AFTER_DRAIN) { E(acc, cur, wr, wc, fr, fq); S.done(cur); }
        if (!has_next) break;
#pragma unroll
        for (int a = 0; a < 2; ++a)
#pragma unroll
            for (int b = 0; b < 2; ++b)
#pragma unroll
                for (int m = 0; m < 4; ++m)
#pragma unroll
                    for (int n = 0; n < 2; ++n) acc[a][b][m][n] = (f32x4){0.f, 0.f, 0.f, 0.f};
        cur = nxt; cA = nA; cB = nB; ++ui;
        if constexpr (ALIGN_EPI) { if (wr == 1) PG8_BAR; }
    }
    PG8_WAIT_V(0);
    if constexpr (!ALIGN_EPI) { if (wr == 0) PG8_BAR; }
    PG8_BAR;
    if constexpr (Epi::AFTER_DRAIN) { E.fused(acc, cur, wr, wc, fr, fq, lds, wid, lane); S.done(cur); }
#undef PG8_SA
#undef PG8_SB
#undef PG8_STAGE
#undef PG8_LDA
#undef PG8_LDB
#undef PG8_MMA
#undef PG8_WAIT_V
#undef PG8_WAIT_L
#undef PG8_BAR
#undef PG8_SCHED
}
}

constexpr int NWAVES = 8;
constexpr int NPH = 15;
#ifndef MK_N_LAUNCHES
#define MK_N_LAUNCHES 1
#endif
constexpr int N_LAUNCHES = MK_N_LAUNCHES;
static_assert(N_LAUNCHES == 1 || N_LAUNCHES == NPH, "MK_N_LAUNCHES is 1 or NPH");

constexpr size_t MiB = 1u << 20;
constexpr size_t WS_CTL = 0, CTL_ZERO_BYTES = 1 * MiB;
constexpr size_t WS_W1U = 2 * MiB, WS_W1D = 13 * MiB, WS_WIN = 19 * MiB, WS_WAB = 30 * MiB, WS_WO = 33 * MiB, WS_W2U = 35 * MiB, WS_W2D = 46 * MiB, WS_ADAW = 52 * MiB;
constexpr size_t WS_AADA = 70 * MiB;
constexpr size_t WS_MOD = 71 * MiB;
constexpr size_t WS_WSP = 77 * MiB;
constexpr size_t WS_XS = 78 * MiB;
constexpr size_t WS_PROJS = 79 * MiB;
constexpr size_t WS_LSE = 82 * MiB;
constexpr size_t WS_XN = 96 * MiB;
constexpr size_t WS_H = 226 * MiB;
constexpr size_t WS_QKV = 226 * MiB;
constexpr size_t WS_U = 514 * MiB;
constexpr size_t WS_VB = 580 * MiB;
constexpr size_t WS_SA = 644 * MiB, WS_SB = 772 * MiB;
constexpr size_t WS_AG = 900 * MiB;
constexpr size_t WS_MG = 1062 * MiB;
constexpr size_t WS_END = 1192 * MiB;
static_assert(WS_W1U + (size_t)2 * FF * D * 2 <= WS_W1D && WS_W1D + (size_t)D * FF * 2 <= WS_WIN && WS_WIN + (size_t)DIN * D * 2 <= WS_WAB && WS_WAB + (size_t)D * KAG * 2 <= WS_WO && WS_WO + (size_t)D * D * 2 <= WS_W2U, "ws map 1");
static_assert(WS_W2U + (size_t)2 * FF * D * 2 <= WS_W2D && WS_W2D + (size_t)D * FF * 2 <= WS_ADAW && WS_ADAW + (size_t)NADA * D * 2 <= WS_AADA && WS_MOD + (size_t)NMOD * NADA * 4 <= WS_WSP, "ws map 2");
static_assert(WS_PROJS + (size_t)DB * DIN * 4 <= WS_LSE && WS_LSE + (size_t)MP * 12 * 4 <= WS_XN && WS_XN + (size_t)MPAD * D * 2 <= WS_H && WS_H + (size_t)MPAD * FF * 2 <= WS_VB, "ws map 3");
static_assert(WS_QKV + (size_t)MP * 2304 * 2 <= WS_U && WS_U + (size_t)MP * DG * 2 <= WS_VB && WS_VB + (size_t)MP * DG * 2 <= WS_SA && WS_SA + (size_t)MP * D * 2 <= WS_SB && WS_SB + (size_t)MP * D * 2 <= WS_AG, "ws map 4");
static_assert(WS_AG + (size_t)MPAD * KAG * 2 <= WS_MG && WS_MG + (size_t)MPAD * D * 2 <= WS_END, "ws map 5");
constexpr int CW_BAR = 4096;

constexpr int RING_OFF = 0, RING_BYTES = 131072;
constexpr int LDSCTL_OFF = RING_BYTES, MISC_OFF = LDSCTL_OFF + 320;
constexpr int SMP_OFF = RING_BYTES + 1024;
constexpr int LDS_BYTES = 147456;
static_assert(MISC_OFF + 128 <= SMP_OFF && SMP_OFF + 10240 <= LDS_BYTES, "LDS map");

#define RLX_AGENT __ATOMIC_RELAXED, __HIP_MEMORY_SCOPE_AGENT
#define LDS_WAIT() asm volatile("s_waitcnt lgkmcnt(0)" ::: "memory")
#define VM_WAIT() asm volatile("s_waitcnt vmcnt(0)" ::: "memory")

#define XB_TMO      128
#define XB_XCNT(j)  (256  + 64 * (j))
#define XB_XSUB(j)  (1280 + 64 * (j))
#define XB_XGEN(j)  (2304 + 64 * (j))
#define XB_TOP      3328
#define XB_TOPGEN   3392
#define XCD_BAR_WORDS 3456
#define XB_SPIN_CAP (1u << 18)

__device__ __forceinline__ unsigned xb_ld(unsigned* p)              { return __hip_atomic_load(p, __ATOMIC_RELAXED, __HIP_MEMORY_SCOPE_AGENT); }
__device__ __forceinline__ unsigned xb_add(unsigned* p, unsigned v) { return __hip_atomic_fetch_add(p, v, __ATOMIC_RELAXED, __HIP_MEMORY_SCOPE_AGENT); }
__device__ __forceinline__ unsigned xb_xcc_id() { return (unsigned)__builtin_amdgcn_s_getreg((3 << 11) | 20) & 0xFu; }
#define XB_SPIN(cond, bar) do { unsigned _sp = 0; while (cond) { __builtin_amdgcn_s_sleep(1); \
    if ((++_sp & 255u) == 0u) { if (xb_ld(&(bar)[XB_TMO])) break; if (_sp > XB_SPIN_CAP) { atomicAdd(&(bar)[XB_TMO], 1u); break; } } } } while (0)

struct XcdBarrier {
    unsigned* bar; unsigned x;
    volatile LAS unsigned* st;
};

__device__ __forceinline__ XcdBarrier xcd_barrier_post(unsigned* bar, volatile LAS unsigned* st) {
    XcdBarrier b; b.bar = bar; b.x = xb_xcc_id(); b.st = st;
    if (threadIdx.x == 0) (void)xb_add(&bar[XB_XCNT(b.x)], 1u);
    return b;
}
__device__ __forceinline__ void xcd_barrier_complete(unsigned* bar, unsigned x, unsigned& nloc, unsigned& nx) {
    const unsigned G = gridDim.x * gridDim.y * gridDim.z;
    unsigned sum, cnt, mine, sp = 0u;
    for (;;) {
        sum = 0u; cnt = 0u; mine = 0u;
#pragma unroll
        for (unsigned j = 0; j < 16; ++j) { const unsigned c = xb_ld(&bar[XB_XCNT(j)]); sum += c; cnt += (c > 0u) ? 1u : 0u; mine = (j == x) ? c : mine; }
        if (sum == G) break;
        __builtin_amdgcn_s_sleep(1);
        if ((++sp & 255u) == 0u) { if (xb_ld(&bar[XB_TMO])) break; if (sp > XB_SPIN_CAP) { atomicAdd(&bar[XB_TMO], 1u); break; } }
    }
    nloc = mine > 0u ? mine : 1u; nx = cnt > 0u ? cnt : 1u;
}

__device__ __forceinline__ void xcd_barrier(const XcdBarrier& b) {
    asm volatile("s_waitcnt vmcnt(0)" ::: "memory");
    __syncthreads();
    if (threadIdx.x == 0) {
        unsigned* bar = b.bar;
        __builtin_amdgcn_s_waitcnt(0);
        unsigned nloc = b.st[0], nx = b.st[1];
        if (nloc == 0u) { xcd_barrier_complete(bar, b.x, nloc, nx); b.st[0] = nloc; b.st[1] = nx; }
        const unsigned old = xb_add(&bar[XB_XSUB(b.x)], 1u);
        const unsigned gen = old / nloc;
        if (old + 1u == (gen + 1u) * nloc) {
            __builtin_amdgcn_fence(__ATOMIC_RELEASE, "agent");
            asm volatile("s_waitcnt vmcnt(0)" ::: "memory");
            const unsigned og = xb_add(&bar[XB_TOP], 1u);
            const unsigned tg = og / nx;
            if (og + 1u == (tg + 1u) * nx) xb_add(&bar[XB_TOPGEN], 1u);
            else XB_SPIN(xb_ld(&bar[XB_TOPGEN]) == tg, bar);
            __builtin_amdgcn_fence(__ATOMIC_ACQUIRE, "agent");
            xb_add(&bar[XB_XGEN(b.x)], 1u);
            asm volatile("s_waitcnt vmcnt(0)" ::: "memory");
        } else {
            XB_SPIN(xb_ld(&bar[XB_XGEN(b.x)]) == gen, bar);
            __builtin_amdgcn_fence(__ATOMIC_ACQUIRE, "agent");
            asm volatile("s_waitcnt vmcnt(0)" ::: "memory");
        }
    }
    __syncthreads();
}

__device__ __forceinline__ float wave_sum(float v) {
#pragma unroll
    for (int o = 1; o < 64; o <<= 1) v += __shfl_xor(v, o);
    return v;
}
__device__ __forceinline__ float wave_max(float v) {
#pragma unroll
    for (int o = 1; o < 64; o <<= 1) v = fmaxf(v, __shfl_xor(v, o));
    return v;
}
__device__ __forceinline__ unsigned offb(unsigned row, unsigned ch) { return 256u * row + 16u * (ch ^ (((row & 3u) << 2) | ((row >> 2) & 3u))); }
typedef short v4i16_t __attribute__((ext_vector_type(4)));
__device__ __forceinline__ s16x4 tr_read(LAS unsigned char* p) { return __builtin_bit_cast(s16x4, __builtin_amdgcn_ds_read_tr16_b64_v4i16((LAS v4i16_t*)p)); }
__device__ __forceinline__ int crow(int reg, int h) { return (reg & 3) + 8 * (reg >> 2) + 4 * h; }
#define MFMA32(a, b, c) __builtin_amdgcn_mfma_f32_32x32x16_bf16((a), (b), (c), 0, 0, 0)
#define MFMA16(a, b, c) __builtin_amdgcn_mfma_f32_16x16x32_bf16((a), (b), (c), 0, 0, 0)

struct Args { const float* in[23]; float* out; unsigned char* ws; int ph_lo, ph_hi; };

__device__ __forceinline__ void p0_transpose_item(const float* W, int K, int N, bf16_t* WT, int ldt, int koff, int mode, LAS float* scr, int item, int lane) {
    const int nblk = N / 32, kb = item / nblk, nb = item % nblk, k0 = 64 * kb, n0 = 32 * nb;
#pragma unroll 8
    for (int i = 0; i < 32; ++i) { const int kk = 2 * i + (lane >> 5); scr[kk * 33 + (lane & 31)] = W[(size_t)(k0 + kk) * N + n0 + (lane & 31)]; }
    LDS_WAIT(); asm volatile("" ::: "memory");
    int rbase = n0;
    if (mode == 1) { const int j = n0 >= FF ? n0 - FF : n0; rbase = 256 * (j >> 7) + (j & 127) + (n0 >= FF ? 128 : 0); }
    const int c = lane & 7;
#pragma unroll
    for (int j = 0; j < 4; ++j) { const int n = (lane >> 3) + 8 * j; const LAS float* s = scr + (8 * c) * 33 + n;
        u32x4 o; o.x = cvt_pk_bf16(s[0 * 33], s[1 * 33]); o.y = cvt_pk_bf16(s[2 * 33], s[3 * 33]); o.z = cvt_pk_bf16(s[4 * 33], s[5 * 33]); o.w = cvt_pk_bf16(s[6 * 33], s[7 * 33]);
        *(u32x4*)(WT + (size_t)(rbase + n) * ldt + koff + k0 + 8 * c) = o; }
    LDS_WAIT(); asm volatile("" ::: "memory");
}
__device__ __forceinline__ void kv_copy(const float* cache, float* outp, int L, size_t gt, size_t NT) {
    const size_t n4 = (size_t)DB * L * 128;
    const f32x4* src = (const f32x4*)cache + 128; f32x4* dst = (f32x4*)outp;
    for (size_t i = gt; i < n4; i += 4 * NT) {
        f32x4 v[4]; bool ok[4];
#pragma unroll
        for (int j = 0; j < 4; ++j) { const size_t k = i + j * NT; ok[j] = k < n4 && (int)((k >> 7) % (size_t)L) != L - 1; if (ok[j]) v[j] = __builtin_nontemporal_load(src + k); }
#pragma unroll
        for (int j = 0; j < 4; ++j) { const size_t k = i + j * NT; if (ok[j]) __builtin_nontemporal_store(v[j], dst + k); }
    }
}

template <int NBF>
__device__ __forceinline__ void skinny_dot(f32x4 (&acc)[NBF], const bf16_t* ap, const bf16_t* bp0, const bf16_t* bp1, int nsteps) {
    for (int s = 0; s < nsteps; s += 8) {
        bf16x8 a[8], b0[8], b1[8];
#pragma unroll
        for (int j = 0; j < 8; ++j) { a[j] = *(const bf16x8*)(ap + (s + j) * 32); b0[j] = *(const bf16x8*)(bp0 + (s + j) * 32); if (NBF > 1) b1[j] = *(const bf16x8*)(bp1 + (s + j) * 32); }
#pragma unroll
        for (int j = 0; j < 8; ++j) { acc[0] = MFMA16(b0[j], a[j], acc[0]); if (NBF > 1) acc[1] = MFMA16(b1[j], a[j], acc[1]); }
    }
}

__device__ __forceinline__ void norm_mod_rows(const float* X, const float* XSmp, const float* gain, const float* mod, int idx, bf16_t* XN, int gw, int NGW, int lane) {
    for (int blk = gw; blk < MP / 32 + DB; blk += NGW) {
        const bool smp = blk >= MP / 32;
        const int b = smp ? NB + (blk - MP / 32) : (blk >> 7);
        const float* mp = mod + (size_t)b * NADA + (3 * idx) * D;
        f32x4 ca[4], cs[4];
#pragma unroll
        for (int j = 0; j < 4; ++j) { const int col = 4 * lane + 256 * j; const f32x4 gg = *(const f32x4*)(gain + col), sc = *(const f32x4*)(mp + D + col); ca[j] = gg * (sc + 1.0f); cs[j] = *(const f32x4*)(mp + col); }
        const int nrows = smp ? 1 : 32;
        const float* src = smp ? XSmp + (size_t)(blk - MP / 32) * D : X + (size_t)blk * 32 * D;
        bf16_t* dst = XN + (smp ? (size_t)(MP + blk - MP / 32) : (size_t)blk * 32) * D;
        for (int rr = 0; rr < nrows; ++rr) {
            f32x4 v[4]; float ss = 0.f;
#pragma unroll
            for (int j = 0; j < 4; ++j) { v[j] = *(const f32x4*)(src + (size_t)rr * D + 4 * lane + 256 * j); ss += (v[j][0] * v[j][0] + v[j][1] * v[j][1]) + (v[j][2] * v[j][2] + v[j][3] * v[j][3]); }
            const float r = __builtin_amdgcn_rsqf(wave_sum(ss) * (1.0f / D) + EPS);
#pragma unroll
            for (int j = 0; j < 4; ++j) { const f32x4 o = v[j] * r * ca[j] + cs[j]; u32x2 w; w.x = cvt_pk_bf16(o[0], o[1]); w.y = cvt_pk_bf16(o[2], o[3]); *(u32x2*)(dst + (size_t)rr * D + 4 * lane + 256 * j) = w; }
        }
    }
}
__device__ __forceinline__ void final_norm_rows(float* Y, const float* XSmp, float* YS, const float* gain, int gw, int NGW, int lane) {
    f32x4 cg[4];
#pragma unroll
    for (int j = 0; j < 4; ++j) cg[j] = *(const f32x4*)(gain + 4 * lane + 256 * j);
    for (int blk = gw; blk < MP / 32 + DB; blk += NGW) {
        const bool smp = blk >= MP / 32;
        const int nrows = smp ? 1 : 32;
        const float* src = smp ? XSmp + (size_t)(blk - MP / 32) * D : Y + (size_t)blk * 32 * D;
        float* dst = smp ? YS + (size_t)(blk - MP / 32) * D : Y + (size_t)blk * 32 * D;
        for (int rr = 0; rr < nrows; ++rr) {
            f32x4 v[4]; float ss = 0.f;
#pragma unroll
            for (int j = 0; j < 4; ++j) { v[j] = *(const f32x4*)(src + (size_t)rr * D + 4 * lane + 256 * j); ss += (v[j][0] * v[j][0] + v[j][1] * v[j][1]) + (v[j][2] * v[j][2] + v[j][3] * v[j][3]); }
            const float r = __builtin_amdgcn_rsqf(wave_sum(ss) * (1.0f / D) + EPS);
#pragma unroll
            for (int j = 0; j < 4; ++j) *(f32x4*)(dst + (size_t)rr * D + 4 * lane + 256 * j) = v[j] * r * cg[j];
        }
    }
}

__device__ __forceinline__ void attn_prompt_unit(LAS unsigned char* lds, const bf16_t* QKV, bf16_t* AG, float* LSE, int unit, int tid, int wave, int lane) {
    const int hp = unit & 1, rn = (unit >> 1) & 31, gb = unit >> 6, g = gb % 3, b = gb / 3;
    const int dsh = 2 * g, dil = 1 << dsh, r = rn & (dil - 1), n = rn >> dsh;
    const size_t tok0 = (size_t)b * SEQ + r;
    const int head0 = 4 * g + 2 * hp;
    LAS unsigned char* Kimg = lds; LAS unsigned char* Vimg = lds + 65536;
    const int jj_lo = (n == 0) ? 128 : 0;
#pragma unroll
    for (int it = 0; it < 8; ++it) {
        const int cid = it * 512 + tid, row = cid >> 4, ch = cid & 15;
        if (row >= jj_lo) {
            const size_t tok = tok0 + ((size_t)((n - 1) * 128 + row) << dsh);
            const bf16_t* src = QKV + tok * 2304 + head0 * 64 + ch * 8;
            const u32x4 kv = *(const u32x4*)(src + DATT), vv = *(const u32x4*)(src + 2 * DATT);
            *(LAS u32x4*)(Kimg + offb(row, ch)) = kv; *(LAS u32x4*)(Vimg + offb(row, ch)) = vv;
        }
    }
    const int hsel = wave >> 2, qsub = wave & 3, ql = lane & 31, h = lane >> 5;
    const size_t tokq = tok0 + ((size_t)(n * 128 + 32 * qsub + ql) << dsh);
    bf16x8 qf[4];
    { const bf16_t* qp = QKV + tokq * 2304 + (head0 + hsel) * 64 + 8 * h;
#pragma unroll
      for (int dc = 0; dc < 4; ++dc) qf[dc] = *(const bf16x8*)(qp + 16 * dc); }
    __syncthreads();
    f32x16 S[5];
    float mx = -INFINITY;
#pragma unroll
    for (int tt = 0; tt < 5; ++tt) {
        const int jt = qsub + tt;
        const bool tv = !(n == 0 && jt < 4);
        f32x16 s;
#pragma unroll
        for (int i = 0; i < 16; ++i) s[i] = 0.f;
        if (tv) {
#pragma unroll
            for (int dc = 0; dc < 4; ++dc) { const bf16x8 kf = *(const LAS bf16x8*)(Kimg + offb(32 * jt + ql, hsel * 8 + 2 * dc + h)); s = MFMA32(kf, qf[dc], s); }
        }
#pragma unroll
        for (int i = 0; i < 16; ++i) { const int kr = crow(i, h); bool ok = tv; if (tt == 0) ok = ok && (kr >= ql); if (tt == 4) ok = ok && (kr <= ql); s[i] = ok ? s[i] : -INFINITY; mx = fmaxf(mx, s[i]); }
        S[tt] = s;
    }
    mx = fmaxf(mx, __shfl_xor(mx, 32));
    const float cs = 0.125f * 1.44269504089f, mc = mx * cs;
    float l = 0.f;
#pragma unroll
    for (int tt = 0; tt < 5; ++tt)
#pragma unroll
        for (int i = 0; i < 16; ++i) { const float p = __builtin_amdgcn_exp2f(S[tt][i] * cs - mc); S[tt][i] = p; l += p; }
    l += __shfl_xor(l, 32);
    f32x16 o0, o1;
#pragma unroll
    for (int i = 0; i < 16; ++i) { o0[i] = 0.f; o1[i] = 0.f; }
    const int q4 = (lane & 15) >> 2, p4 = lane & 3, blk = (lane >> 4) & 1;
#pragma unroll
    for (int tt = 0; tt < 5; ++tt) {
        const int jt = qsub + tt;
        if (!(n == 0 && jt < 4)) {
#pragma unroll
            for (int s = 0; s < 2; ++s) {
                u32x4 pw;
                pw.x = cvt_pk_bf16(S[tt][8 * s + 0], S[tt][8 * s + 1]); pw.y = cvt_pk_bf16(S[tt][8 * s + 2], S[tt][8 * s + 3]);
                pw.z = cvt_pk_bf16(S[tt][8 * s + 4], S[tt][8 * s + 5]); pw.w = cvt_pk_bf16(S[tt][8 * s + 6], S[tt][8 * s + 7]);
                const bf16x8 pf = __builtin_bit_cast(bf16x8, pw);
                const int row0 = 32 * jt + 16 * s + 4 * h + q4;
#pragma unroll
                for (int c = 0; c < 2; ++c) {
                    const int chv = hsel * 8 + 4 * c + 2 * blk + (p4 >> 1);
                    const s16x4 lo = tr_read(Vimg + offb(row0, chv) + 8 * (p4 & 1)), hi = tr_read(Vimg + offb(row0 + 8, chv) + 8 * (p4 & 1));
                    const bf16x8 vf = __builtin_shufflevector(lo, hi, 0, 1, 2, 3, 4, 5, 6, 7);
                    if (c == 0) o0 = MFMA32(vf, pf, o0); else o1 = MFMA32(vf, pf, o1);
                }
            }
        }
    }
    const float inv = 1.0f / l;
    bf16_t* op = AG + tokq * KAG + (head0 + hsel) * 64 + 4 * h;
#pragma unroll
    for (int gq = 0; gq < 4; ++gq) {
        u32x2 w0, w1;
        w0.x = cvt_pk_bf16(o0[4 * gq] * inv, o0[4 * gq + 1] * inv); w0.y = cvt_pk_bf16(o0[4 * gq + 2] * inv, o0[4 * gq + 3] * inv);
        w1.x = cvt_pk_bf16(o1[4 * gq] * inv, o1[4 * gq + 1] * inv); w1.y = cvt_pk_bf16(o1[4 * gq + 2] * inv, o1[4 * gq + 3] * inv);
        *(u32x2*)(op + 8 * gq) = w0; *(u32x2*)(op + 32 + 8 * gq) = w1;
    }
    if (h == 0) LSE[tokq * 12 + head0 + hsel] = mx * 0.125f + __logf(l);
    __syncthreads();
}

__device__ __forceinline__ void gmlp_unit(LAS unsigned char* lds, const bf16_t* VB, const bf16_t* U, const bf16_t* WSP, const float* bsp, const float* lng, const float* lnb, bf16_t* AG, float* out,
                                          int unit, int wave, int lane) {
    const int b = unit >> 5, c = unit & 31;
    const size_t tokb = (size_t)b * SEQ + c * 128;
    {
        const f32x4 g0 = *(const f32x4*)(lng + 8 * lane), g1 = *(const f32x4*)(lng + 8 * lane + 4), b0 = *(const f32x4*)(lnb + 8 * lane), b1 = *(const f32x4*)(lnb + 8 * lane + 4);
        LAS unsigned char* img = lds + (lane >> 4) * 32768;
#pragma unroll 4
        for (int jr = 0; jr < 16; ++jr) {
            const int j = 16 * wave + jr;
            const u32x4 x = *(const u32x4*)(VB + (tokb + j) * DG + 8 * lane);
            f32x4 v0, v1; v0[0] = bflo(x.x); v0[1] = bfhi(x.x); v0[2] = bflo(x.y); v0[3] = bfhi(x.y); v1[0] = bflo(x.z); v1[1] = bfhi(x.z); v1[2] = bflo(x.w); v1[3] = bfhi(x.w);
            const float mean = wave_sum((v0[0] + v0[1]) + (v0[2] + v0[3]) + (v1[0] + v1[1]) + (v1[2] + v1[3])) * (1.0f / DG);
            v0 = v0 - mean; v1 = v1 - mean;
            const float var = wave_sum((v0[0] * v0[0] + v0[1] * v0[1]) + (v0[2] * v0[2] + v0[3] * v0[3]) + (v1[0] * v1[0] + v1[1] * v1[1]) + (v1[2] * v1[2] + v1[3] * v1[3])) * (1.0f / DG);
            const float rstd = __builtin_amdgcn_rsqf(var + EPS);
            v0 = v0 * rstd * g0 + b0; v1 = v1 * rstd * g1 + b1;
            if (c == 31) { float* vo = out + O_VRP + ((size_t)b * 128 + j) * DG + 8 * lane; *(f32x4*)vo = v0; *(f32x4*)(vo + 4) = v1; }
            u32x4 w; w.x = cvt_pk_bf16(v0[0], v0[1]); w.y = cvt_pk_bf16(v0[2], v0[3]); w.z = cvt_pk_bf16(v1[0], v1[1]); w.w = cvt_pk_bf16(v1[2], v1[3]);
            *(LAS u32x4*)(img + offb(j, lane & 15)) = w;
        }
    }
    __syncthreads();
    const int grp = wave >> 1, ql = lane & 31, h = lane >> 5, q4 = (lane & 15) >> 2, p4 = lane & 3, blk = (lane >> 4) & 1;
    LAS unsigned char* img = lds + grp * 32768;
    const bf16_t* wg = WSP + (size_t)grp * 128 * 128 + 8 * h;
#pragma unroll 1
    for (int cc = 0; cc < 2; ++cc) {
        const int c32 = (wave & 1) * 2 + cc;
        f32x16 acc[4];
#pragma unroll
        for (int it = 0; it < 4; ++it)
#pragma unroll
            for (int i = 0; i < 16; ++i) acc[it][i] = 0.f;
        const int chv = 4 * c32 + 2 * blk + (p4 >> 1);
#pragma unroll
        for (int s = 0; s < 8; ++s) {
            const int row0 = 16 * s + 8 * h + q4;
            const s16x4 lo = tr_read(img + offb(row0, chv) + 8 * (p4 & 1)), hi = tr_read(img + offb(row0 + 4, chv) + 8 * (p4 & 1));
            const bf16x8 af = __builtin_shufflevector(lo, hi, 0, 1, 2, 3, 4, 5, 6, 7);
#pragma unroll
            for (int it = s >> 1; it < 4; ++it) { const bf16x8 bfr = *(const bf16x8*)(wg + (size_t)(32 * it + ql) * 128 + 16 * s); acc[it] = MFMA32(af, bfr, acc[it]); }
        }
#pragma unroll
        for (int it = 0; it < 4; ++it) {
            const int i = 32 * it + ql; const float bias = bsp[grp * 128 + i];
            const size_t tok = tokb + i;
            const bf16_t* up = U + tok * DG + grp * 128 + 32 * c32 + 4 * h;
            bf16_t* gp = AG + tok * KAG + DATT + grp * 128 + 32 * c32 + 4 * h;
#pragma unroll
            for (int gq = 0; gq < 4; ++gq) { const u32x2 uu = *(const u32x2*)(up + 8 * gq);
                u32x2 w; w.x = cvt_pk_bf16(bflo(uu.x) * (acc[it][4 * gq] + bias), bfhi(uu.x) * (acc[it][4 * gq + 1] + bias)); w.y = cvt_pk_bf16(bflo(uu.y) * (acc[it][4 * gq + 2] + bias), bfhi(uu.y) * (acc[it][4 * gq + 3] + bias));
                *(u32x2*)(gp + 8 * gq) = w; }
        }
    }
    __syncthreads();
}

__device__ __forceinline__ void sample_unit(LAS unsigned char* lds, const float* PROJS, const float* c0, const float* c1, const float* c2, const float* wsp, const float* bsp, const float* lng, const float* lnb,
                                            bf16_t* AG, float* out, int b, int tid, int wave, int lane) {
    LAS float* qs = (LAS float*)(lds + SMP_OFF) + wave * 64;
    LAS float* ps = (LAS float*)(lds + SMP_OFF + 2048) + wave * 128;
    LAS float* osh = (LAS float*)(lds + SMP_OFF + 6144);
    LAS float* lsv = (LAS float*)(lds + SMP_OFF + 9216);
    const float* pr = PROJS + (size_t)b * DIN;
#pragma unroll 1
    for (int head = wave; head < 12; head += 8) {
        const int g = head >> 2, hh = head & 3, dsh = 2 * g, L = 128 << dsh;
        const float* cg = (g == 0 ? c0 : (g == 1 ? c1 : c2)) + (size_t)b * L * 512;
        const float qv = pr[head * 64 + lane];
        qs[lane] = qv;
        LDS_WAIT(); asm volatile("" ::: "memory");
        float sc[2];
#pragma unroll
        for (int kk = 0; kk < 2; ++kk) {
            const float* kp = cg + ((size_t)(lane + 64 * kk) << dsh) * 512 + hh * 64;
            float d = 0.f;
#pragma unroll
            for (int j = 0; j < 16; ++j) { const f32x4 kv = *(const f32x4*)(kp + 4 * j); const f32x4 q4v = *(const LAS f32x4*)(qs + 4 * j); d += (kv[0] * q4v[0] + kv[1] * q4v[1]) + (kv[2] * q4v[2] + kv[3] * q4v[3]); }
            sc[kk] = d * 0.125f;
        }
        const float snew = wave_sum(qv * pr[DATT + head * 64 + lane]) * 0.125f;
        const float mx = wave_max(fmaxf(fmaxf(sc[0], sc[1]), snew));
        const float p0 = __expf(sc[0] - mx), p1 = __expf(sc[1] - mx), pn = __expf(snew - mx);
        const float l = wave_sum(p0 + p1) + pn;
        ps[lane] = p0; ps[lane + 64] = p1;
        LDS_WAIT(); asm volatile("" ::: "memory");
        float o = pn * pr[2 * DATT + head * 64 + lane];
        const float* vp = cg + 256 + hh * 64 + lane;
#pragma unroll 8
        for (int m = 0; m < 128; ++m) o += ps[m] * vp[((size_t)m << dsh) * 512];
        osh[head * 64 + lane] = o / l;
        if (lane == 0) lsv[head] = mx + __logf(l);
        LDS_WAIT(); asm volatile("" ::: "memory");
    }
    __syncthreads();
    for (int t = tid; t < DATT; t += NWAVES * 64) {
        const int head = t >> 6, hh = head & 3, g = head >> 2;
        const float l0 = lsv[hh], l1 = lsv[4 + hh], l2 = lsv[8 + hh], m = fmaxf(l0, fmaxf(l1, l2));
        const float e0 = __expf(l0 - m), e1 = __expf(l1 - m), e2 = __expf(l2 - m);
        const float w = (g == 0 ? e0 : (g == 1 ? e1 : e2)) / (e0 + e1 + e2);
        AG[(size_t)(MP + b) * KAG + t] = (bf16_t)(cvt_pk_bf16(osh[t] * w, 0.f) & 0xffffu);
    }
    if (wave == 4) {
        const int grp = lane >> 4;
        f32x4 v0 = *(const f32x4*)(pr + 2816 + 8 * lane), v1 = *(const f32x4*)(pr + 2816 + 8 * lane + 4);
        const float mean = wave_sum((v0[0] + v0[1]) + (v0[2] + v0[3]) + (v1[0] + v1[1]) + (v1[2] + v1[3])) * (1.0f / DG);
        v0 = v0 - mean; v1 = v1 - mean;
        const float var = wave_sum((v0[0] * v0[0] + v0[1] * v0[1]) + (v0[2] * v0[2] + v0[3] * v0[3]) + (v1[0] * v1[0] + v1[1] * v1[1]) + (v1[2] * v1[2] + v1[3] * v1[3])) * (1.0f / DG);
        const float rstd = __builtin_amdgcn_rsqf(var + EPS);
        v0 = v0 * rstd * *(const f32x4*)(lng + 8 * lane) + *(const f32x4*)(lnb + 8 * lane); v1 = v1 * rstd * *(const f32x4*)(lng + 8 * lane + 4) + *(const f32x4*)(lnb + 8 * lane + 4);
        float* vo = out + O_VRS + (size_t)b * DG + 8 * lane; *(f32x4*)vo = v0; *(f32x4*)(vo + 4) = v1;
        const float w00 = wsp[(size_t)grp * 128 * 128], b00 = bsp[grp * 128];
        const f32x4 u0 = *(const f32x4*)(pr + 2304 + 8 * lane), u1 = *(const f32x4*)(pr + 2304 + 8 * lane + 4);
        const f32x4 m0 = u0 * (v0 * w00 + b00), m1 = u1 * (v1 * w00 + b00);
        u32x4 w; w.x = cvt_pk_bf16(m0[0], m0[1]); w.y = cvt_pk_bf16(m0[2], m0[3]); w.z = cvt_pk_bf16(m1[0], m1[1]); w.w = cvt_pk_bf16(m1[2], m1[3]);
        *(u32x4*)(AG + (size_t)(MP + b) * KAG + DATT + 8 * lane) = w;
    }
    __syncthreads();
}


#define INP(k) (args.in[k])
#define WSB(off) ((bf16_t*)(ws + (off)))
#define WSF(off) ((float*)(ws + (off)))
#define x_prompt INP(0)
#define x_sample INP(1)
#define c_prompt INP(2)
#define c_sample INP(3)
#define cache0 INP(4)
#define cache1 INP(5)
#define cache2 INP(6)
#define ada_w INP(7)
#define ada_b INP(8)
#define norm_g INP(9)
#define ffn1_up INP(10)
#define ffn1_down INP(11)
#define w_in INP(12)
#define w_ba INP(13)
#define w_bb INP(14)
#define w_out INP(15)
#define v_ln_g INP(16)
#define v_ln_b INP(17)
#define w_sp INP(18)
#define b_sp INP(19)
#define ffn2_up INP(20)
#define ffn2_down INP(21)
#define final_g INP(22)
#define W1U WSB(WS_W1U)
#define W1D WSB(WS_W1D)
#define WIN WSB(WS_WIN)
#define WAB WSB(WS_WAB)
#define WO WSB(WS_WO)
#define W2U WSB(WS_W2U)
#define W2D WSB(WS_W2D)
#define ADAW WSB(WS_ADAW)
#define AADA WSB(WS_AADA)
#define MOD WSF(WS_MOD)
#define WSP WSB(WS_WSP)
#define XS WSF(WS_XS)
#define PROJS WSF(WS_PROJS)
#define LSE WSF(WS_LSE)
#define XN WSB(WS_XN)
#define HB WSB(WS_H)
#define QKV WSB(WS_QKV)
#define UB WSB(WS_U)
#define VBB WSB(WS_VB)
#define SA WSB(WS_SA)
#define SB WSB(WS_SB)
#define AG WSB(WS_AG)
#define MG WSB(WS_MG)
#define YP (out + O_YP)
#define LANE_VARS() int tidv = threadIdx.x; asm volatile("" : "+v"(tidv)); const int lane = tidv & 63, fr = lane & 15, fq = lane >> 4; (void)lane; (void)fr; (void)fq
__global__ void __launch_bounds__(NWAVES * 64, 2) fwd_kernel(Args args) {
    extern __shared__ __attribute__((aligned(16))) unsigned char lds_raw[];
    LAS unsigned char* lds = (LAS unsigned char*)lds_raw;
    const int tid = threadIdx.x, wave = __builtin_amdgcn_readfirstlane(tid >> 6);
    const int G = gridDim.x, bx = blockIdx.x;
    const int vcu = (G % 8 == 0) ? (bx % 8) * (G / 8) + bx / 8 : bx;
    const int gw = vcu * NWAVES + wave, NGW = G * NWAVES;
    const size_t gt = (size_t)vcu * (NWAVES * 64) + tid, NT = (size_t)G * (NWAVES * 64);
    unsigned char* ws = args.ws;
    unsigned* ctl = (unsigned*)(ws + WS_CTL);
    for (int u = tid; u < (LDS_BYTES - LDSCTL_OFF) / 4; u += NWAVES * 64) ((LAS unsigned*)(lds + LDSCTL_OFF))[u] = 0u;
    __syncthreads();
    volatile LAS unsigned* MISC = (volatile LAS unsigned*)(lds + MISC_OFF);
    XcdBarrier bar; bar.bar = ctl + CW_BAR; bar.x = 0; bar.st = nullptr;
    if (N_LAUNCHES == 1) bar = xcd_barrier_post(ctl + CW_BAR, MISC + 8);
#define GRID_BAR() do { if (N_LAUNCHES == 1) xcd_barrier(bar); } while (0)
    const int lo = args.ph_lo, hi = args.ph_hi;
#define IN(k) (lo <= (k) && (k) < hi)
#define BOTH(k) (IN(k) && IN((k) + 1))
    float* const out = args.out;
#if SIMPLE_GEMM
#define RUN_GEMM(EPI, g, S, E) pg8::gemm_simple<EPI, pg8::StaticOrder>(g, S, E)
#else
#define RUN_GEMM(EPI, g, S, E) pg8::gemm_phase<EPI, pg8::StaticOrder, true, true>(lds + RING_OFF, g, S, E)
#endif

    if (IN(0)) {
        LANE_VARS();
        LAS float* scr = (LAS float*)(lds + RING_OFF + wave * 16384);
        constexpr int I_ADA = (D / 64) * (NADA / 32), I_UP = (D / 64) * (2 * FF / 32), I_DN = (FF / 64) * (D / 32), I_IN = (D / 64) * (DIN / 32), I_A = (DATT / 64) * (D / 32), I_B = (DG / 64) * (D / 32), I_O = (D / 64) * (D / 32);
        constexpr int NITEMS = I_ADA + 2 * I_UP + 2 * I_DN + I_IN + I_A + I_B + I_O;
        for (int it = gw; it < NITEMS; it += NGW) {
            int r = it;
            if (r < I_ADA) { p0_transpose_item(ada_w, D, NADA, ADAW, D, 0, 0, scr, r, lane); continue; } r -= I_ADA;
            if (r < I_UP) { p0_transpose_item(ffn1_up, D, 2 * FF, W1U, D, 0, 1, scr, r, lane); continue; } r -= I_UP;
            if (r < I_DN) { p0_transpose_item(ffn1_down, FF, D, W1D, FF, 0, 0, scr, r, lane); continue; } r -= I_DN;
            if (r < I_IN) { p0_transpose_item(w_in, D, DIN, WIN, D, 0, 0, scr, r, lane); continue; } r -= I_IN;
            if (r < I_A) { p0_transpose_item(w_ba, DATT, D, WAB, KAG, 0, 0, scr, r, lane); continue; } r -= I_A;
            if (r < I_B) { p0_transpose_item(w_bb, DG, D, WAB, KAG, DATT, 0, scr, r, lane); continue; } r -= I_B;
            if (r < I_O) { p0_transpose_item(w_out, D, D, WO, D, 0, 0, scr, r, lane); continue; } r -= I_O;
            if (r < I_UP) { p0_transpose_item(ffn2_up, D, 2 * FF, W2U, D, 0, 1, scr, r, lane); continue; } r -= I_UP;
            p0_transpose_item(ffn2_down, FF, D, W2D, FF, 0, 0, scr, r, lane);
        }
        for (size_t i = gt; i < (size_t)NMOD * D / 4; i += NT) {
            const f32x4 c = (i < (size_t)NB * D / 4) ? ((const f32x4*)c_prompt)[i] : ((const f32x4*)c_sample)[i - (size_t)NB * D / 4];
            u32x2 w; w.x = cvt_pk_bf16(siluf_(c[0]), siluf_(c[1])); w.y = cvt_pk_bf16(siluf_(c[2]), siluf_(c[3]));
            ((u32x2*)AADA)[i] = w;
        }
        for (size_t i = gt; i < (size_t)4 * 128 * 128 / 4; i += NT) {
            const int j0 = (int)(i & 31) * 4, rr = (int)(i >> 5) & 127;
            const f32x4 v = ((const f32x4*)w_sp)[i];
            u32x2 w; w.x = cvt_pk_bf16(j0 <= rr ? v[0] : 0.f, j0 + 1 <= rr ? v[1] : 0.f); w.y = cvt_pk_bf16(j0 + 2 <= rr ? v[2] : 0.f, j0 + 3 <= rr ? v[3] : 0.f);
            ((u32x2*)WSP)[i] = w;
        }
        kv_copy(cache0, out + O_KV0S, 128, gt, NT);
        kv_copy(cache1, out + O_KV1S, 512, gt, NT);
        kv_copy(cache2, out + O_KV2S, 2048, gt, NT);
        if (BOTH(0)) GRID_BAR();
    }

    if (IN(1)) {
        LANE_VARS();
        for (int it = vcu; it < NADA / 16; it += G)
            for (int rb = wave; rb < NMOD / 16; rb += NWAVES) {
                f32x4 acc[1]; acc[0] = (f32x4){0.f, 0.f, 0.f, 0.f};
                const bf16_t* bp = ADAW + (size_t)(16 * it + fr) * D + 8 * fq;
                skinny_dot<1>(acc, AADA + (size_t)(16 * rb + fr) * D + 8 * fq, bp, bp, D / 32);
                const int col = 16 * it + 4 * fq;
                *(f32x4*)(MOD + (size_t)(16 * rb + fr) * NADA + col) = acc[0] + *(const f32x4*)(ada_b + col);
            }
        if (BOTH(1)) GRID_BAR();
    }

    if (IN(2)) { LANE_VARS(); norm_mod_rows(x_prompt, x_sample, norm_g, MOD, 0, XN, gw, NGW, lane); if (BOTH(2)) GRID_BAR(); }

#define FFN_UP_PHASE(WU) do { \
        for (int it = vcu; it < FF / 16; it += G) {                                      \
            const int j0 = 16 * it, ra = 256 * (j0 >> 7) + (j0 & 127) + fr; \
            f32x4 acc[2]; acc[0] = (f32x4){0.f, 0.f, 0.f, 0.f}; acc[1] = acc[0]; \
            const size_t row = (size_t)MP + 16 * wave + fr; \
            skinny_dot<2>(acc, XN + row * D + 8 * fq, (WU) + (size_t)ra * D + 8 * fq, (WU) + (size_t)(ra + 128) * D + 8 * fq, D / 32); \
            u32x2 w; w.x = cvt_pk_bf16(siluf_(acc[0][0]) * acc[1][0], siluf_(acc[0][1]) * acc[1][1]); w.y = cvt_pk_bf16(siluf_(acc[0][2]) * acc[1][2], siluf_(acc[0][3]) * acc[1][3]); \
            *(u32x2*)(HB + row * FF + j0 + 4 * fq) = w; } \
        pg8::Gemm g{XN, (WU), MP, 2 * FF, D}; pg8::StaticOrder S; S.init(MP, 2 * FF, G, bx); pg8::EpiUp E{HB}; \
        RUN_GEMM(pg8::EpiUp, g, S, E); } while (0)
#define FFN_DOWN_PHASE(WD, BASEP, BASES, GIDX) do { \
        for (int it = vcu; it < D / 16; it += G) { \
            f32x4 acc[1]; acc[0] = (f32x4){0.f, 0.f, 0.f, 0.f}; \
            const int srow = 16 * wave + fr, col = 16 * it + 4 * fq; \
            const bf16_t* bp = (WD) + (size_t)(16 * it + fr) * FF + 8 * fq; \
            skinny_dot<1>(acc, HB + (size_t)(MP + srow) * FF + 8 * fq, bp, bp, FF / 32); \
            const f32x4 gv = *(const f32x4*)(MOD + (size_t)(NB + srow) * NADA + (GIDX) * D + col) * 0.5f; \
            *(f32x4*)(XS + (size_t)srow * D + col) = *(const f32x4*)((BASES) + (size_t)srow * D + col) + gv * acc[0]; } \
        pg8::Gemm g{HB, (WD), MP, D, FF}; pg8::StaticOrder S; S.init(MP, D, G, bx); pg8::EpiResid E{(BASEP), YP, MOD, (GIDX), 0.5f}; \
        RUN_GEMM(pg8::EpiResid, g, S, E); } while (0)

    if (IN(3)) { LANE_VARS(); FFN_UP_PHASE(W1U); if (BOTH(3)) GRID_BAR(); }
    if (IN(4)) { LANE_VARS(); FFN_DOWN_PHASE(W1D, x_prompt, x_sample, 2); if (BOTH(4)) GRID_BAR(); }

    if (IN(5)) { LANE_VARS(); norm_mod_rows(YP, XS, norm_g + D, MOD, 1, XN, gw, NGW, lane); if (BOTH(5)) GRID_BAR(); }

    if (IN(6)) {
        LANE_VARS();
        for (int it = vcu; it < DIN / 16; it += G) {
            f32x4 acc[1]; acc[0] = (f32x4){0.f, 0.f, 0.f, 0.f};
            const int srow = 16 * wave + fr, col = 16 * it + 4 * fq;
            const bf16_t* bp = WIN + (size_t)(16 * it + fr) * D + 8 * fq;
            skinny_dot<1>(acc, XN + (size_t)(MP + srow) * D + 8 * fq, bp, bp, D / 32);
            *(f32x4*)(PROJS + (size_t)srow * DIN + col) = acc[0];
            if (col >= DATT && col < 3 * DATT) {
                const int isv = col >= 2 * DATT ? 1 : 0, cc = col - (isv ? 2 * DATT : DATT), g = cc >> 8, L = 128 << (2 * g);
                const size_t ob = (g == 0 ? O_KV0S : (g == 1 ? O_KV1S : O_KV2S)) + ((size_t)srow * L + (L - 1)) * 512 + isv * 256 + (cc & 255);
                *(f32x4*)(out + ob) = acc[0];
            }
        }
        pg8::Gemm g{XN, WIN, MP, DIN, D}; pg8::StaticOrder S; S.init(MP, DIN, G, bx); pg8::EpiProj E{QKV, UB, VBB, SA, SB, out};
        RUN_GEMM(pg8::EpiProj, g, S, E);
        if (BOTH(6)) GRID_BAR();
    }

    if (IN(7)) {
        LANE_VARS();
        for (int u = vcu; u < NB * 3 * 32 * 2; u += G) attn_prompt_unit(lds + RING_OFF, QKV, AG, LSE, u, tidv, wave, lane);
        for (int u = vcu; u < NB * 32; u += G) gmlp_unit(lds + RING_OFF, VBB, UB, WSP, b_sp, v_ln_g, v_ln_b, AG, out, u, wave, lane);
        for (int u = vcu; u < DB; u += G) sample_unit(lds, PROJS, cache0, cache1, cache2, w_sp, b_sp, v_ln_g, v_ln_b, AG, out, u, tidv, wave, lane);
        if (BOTH(7)) GRID_BAR();
    }

    if (IN(8)) {
        for (size_t i = gt; i < (size_t)MP * 96; i += NT) {
            const size_t t = i / 96; const int ch = (int)(i - t * 96), head = ch >> 3, hh = head & 3, g = head >> 2;
            const float l0 = LSE[t * 12 + hh], l1 = LSE[t * 12 + 4 + hh], l2 = LSE[t * 12 + 8 + hh], m = fmaxf(l0, fmaxf(l1, l2));
            const float e0 = __expf(l0 - m), e1 = __expf(l1 - m), e2 = __expf(l2 - m);
            const float w = (g == 0 ? e0 : (g == 1 ? e1 : e2)) / (e0 + e1 + e2);
            u32x4* p = (u32x4*)(AG + t * KAG + ch * 8); const u32x4 v = *p;
            u32x4 o; o.x = cvt_pk_bf16(bflo(v.x) * w, bfhi(v.x) * w); o.y = cvt_pk_bf16(bflo(v.y) * w, bfhi(v.y) * w); o.z = cvt_pk_bf16(bflo(v.z) * w, bfhi(v.z) * w); o.w = cvt_pk_bf16(bflo(v.w) * w, bfhi(v.w) * w);
            *p = o;
        }
        if (BOTH(8)) GRID_BAR();
    }

    if (IN(9)) {
        LANE_VARS();
        for (int it = vcu; it < D / 16; it += G) {
            f32x4 a0[1], a1[1]; a0[0] = (f32x4){0.f, 0.f, 0.f, 0.f}; a1[0] = a0[0];
            const int srow = 16 * wave + fr, col = 16 * it + 4 * fq;
            const bf16_t* bp = WAB + (size_t)(16 * it + fr) * KAG + 8 * fq; const bf16_t* ap = AG + (size_t)(MP + srow) * KAG + 8 * fq;
            skinny_dot<1>(a0, ap, bp, bp, DATT / 32);
            skinny_dot<1>(a1, ap + DATT, bp + DATT, bp + DATT, DG / 32);
            const f32x4 ga = *(const f32x4*)(PROJS + (size_t)srow * DIN + 3328 + col), gb = *(const f32x4*)(PROJS + (size_t)srow * DIN + 4352 + col);
            u32x2 w; w.x = cvt_pk_bf16(sigmoidf_(ga[0]) * a0[0][0] + sigmoidf_(gb[0]) * a1[0][0], sigmoidf_(ga[1]) * a0[0][1] + sigmoidf_(gb[1]) * a1[0][1]);
            w.y = cvt_pk_bf16(sigmoidf_(ga[2]) * a0[0][2] + sigmoidf_(gb[2]) * a1[0][2], sigmoidf_(ga[3]) * a0[0][3] + sigmoidf_(gb[3]) * a1[0][3]);
            *(u32x2*)(MG + (size_t)(MP + srow) * D + col) = w;
        }
        pg8::Gemm g{AG, WAB, MP, D, KAG}; pg8::StaticOrder S; S.init(MP, D, G, bx); pg8::EpiMerge E{SA, SB, MG};
        RUN_GEMM(pg8::EpiMerge, g, S, E);
        if (BOTH(9)) GRID_BAR();
    }

    if (IN(10)) {
        LANE_VARS();
        for (int it = vcu; it < D / 16; it += G) {
            f32x4 acc[1]; acc[0] = (f32x4){0.f, 0.f, 0.f, 0.f};
            const int srow = 16 * wave + fr, col = 16 * it + 4 * fq;
            const bf16_t* bp = WO + (size_t)(16 * it + fr) * D + 8 * fq;
            skinny_dot<1>(acc, MG + (size_t)(MP + srow) * D + 8 * fq, bp, bp, D / 32);
            const f32x4 gv = *(const f32x4*)(MOD + (size_t)(NB + srow) * NADA + 5 * D + col);
            *(f32x4*)(XS + (size_t)srow * D + col) = *(const f32x4*)(XS + (size_t)srow * D + col) + gv * acc[0];
        }
        pg8::Gemm g{MG, WO, MP, D, D}; pg8::StaticOrder S; S.init(MP, D, G, bx); pg8::EpiResid E{YP, YP, MOD, 5, 1.0f};
        RUN_GEMM(pg8::EpiResid, g, S, E);
        if (BOTH(10)) GRID_BAR();
    }

    if (IN(11)) { LANE_VARS(); norm_mod_rows(YP, XS, norm_g + 2 * D, MOD, 2, XN, gw, NGW, lane); if (BOTH(11)) GRID_BAR(); }

    if (IN(12)) { LANE_VARS(); FFN_UP_PHASE(W2U); if (BOTH(12)) GRID_BAR(); }
    if (IN(13)) { LANE_VARS(); FFN_DOWN_PHASE(W2D, YP, XS, 8); if (BOTH(13)) GRID_BAR(); }

    if (IN(14)) { LANE_VARS(); final_norm_rows(YP, XS, out + O_YS, final_g, gw, NGW, lane); }
#undef IN
#undef BOTH
}

extern "C" void kernel_launch(void* const* d_in, const int* in_sizes, int n_in, void* d_out, int out_size, void* d_ws, size_t ws_size, hipStream_t stream) {
    static int grid = 0;
    if (grid == 0) {
        if (n_in != 23 || in_sizes[0] != MP * D || (size_t)out_size != O_END || ws_size < WS_END) {
            fprintf(stderr, "kernel_launch: unexpected shapes: n_in %d, in0 %d, out %d, ws %zu (need %zu); nothing launched\n", n_in, n_in > 0 ? in_sizes[0] : -1, out_size, ws_size, (size_t)WS_END); grid = -1; return; }
        int dev = 0, cus = 0, per_cu = 0;
        if (hipGetDevice(&dev) != hipSuccess || hipDeviceGetAttribute(&cus, hipDeviceAttributeMultiprocessorCount, dev) != hipSuccess) { fprintf(stderr, "kernel_launch: device query failed\n"); grid = -1; return; }
        if (hipFuncSetAttribute((const void*)fwd_kernel, hipFuncAttributeMaxDynamicSharedMemorySize, LDS_BYTES) != hipSuccess) { fprintf(stderr, "kernel_launch: hipFuncSetAttribute failed\n"); grid = -1; return; }
        if (hipOccupancyMaxActiveBlocksPerMultiprocessor(&per_cu, (const void*)fwd_kernel, NWAVES * 64, LDS_BYTES) != hipSuccess || per_cu < 1)
            fprintf(stderr, "kernel_launch: note: occupancy query reports %d workgroups per CU\n", per_cu);
        (void)hipGetLastError();
        grid = cus;
    }
    if (grid < 0) return;
    if (hipMemsetAsync((char*)d_ws + WS_CTL, 0, CTL_ZERO_BYTES, stream) != hipSuccess) { fprintf(stderr, "kernel_launch: hipMemsetAsync failed\n"); return; }
    Args a{};
    for (int i = 0; i < 23; ++i) a.in[i] = (const float*)d_in[i];
    a.out = (float*)d_out; a.ws = (unsigned char*)d_ws;
    for (int li = 0; li < N_LAUNCHES; ++li) {
        a.ph_lo = (N_LAUNCHES == 1) ? 0 : li; a.ph_hi = (N_LAUNCHES == 1) ? NPH : li + 1;
        hipLaunchKernelGGL(fwd_kernel, dim3(grid), dim3(NWAVES * 64), LDS_BYTES, stream, a);
        const hipError_t le = hipPeekAtLastError();
        if (le != hipSuccess) { fprintf(stderr, "kernel_launch: launch %d failed: %s\n", li, hipGetErrorName(le)); break; }
    }
}
```

```cpp
#include <hip/hip_runtime.h>
#include <cstdio>
#include <cstdint>

#define LAS __attribute__((address_space(3)))
#define GAS __attribute__((address_space(1)))
typedef unsigned short bf16_t;
typedef short bf16x8 __attribute__((ext_vector_type(8)));
typedef short s16x4 __attribute__((ext_vector_type(4)));
typedef float f32x4 __attribute__((ext_vector_type(4)));
typedef float f32x2 __attribute__((ext_vector_type(2)));
typedef float f32x16 __attribute__((ext_vector_type(16)));
typedef unsigned u32x4 __attribute__((ext_vector_type(4)));
typedef unsigned u32x2 __attribute__((ext_vector_type(2)));
typedef GAS unsigned gu32;

#ifndef SIMPLE_GEMM
#define SIMPLE_GEMM 0
#endif

constexpr int D = 1024, NB = 16, SEQ = 4096, MP = NB * SEQ  , DB = 128  , MPAD = MP + 256;
constexpr int FF = 2816, DIN = 5376, DATT = 768, DG = 512, KAG = DATT + DG  , NADA = 9 * D;
constexpr int NMOD = NB + DB;
constexpr float EPS = 1e-6f;
constexpr size_t O_YP = 0, O_YS = 67108864, O_KV0P = 67239936, O_KV1P = 68288512, O_KV2P = 72482816, O_VRP = 89260032,
                 O_KV0S = 90308608, O_KV1S = 98697216, O_KV2S = 132251648, O_VRS = 266469376, O_END = 266534912;

__device__ __forceinline__ unsigned cvt_pk_bf16(float lo, float hi) { unsigned r; asm volatile("v_cvt_pk_bf16_f32 %0, %1, %2" : "=v"(r) : "v"(lo), "v"(hi)); return r; }
__device__ __forceinline__ float bf2f(unsigned short b) { return __uint_as_float((unsigned)b << 16); }
__device__ __forceinline__ float bflo(unsigned w) { return __uint_as_float(w << 16); }
__device__ __forceinline__ float bfhi(unsigned w) { return __uint_as_float(w & 0xffff0000u); }
__device__ __forceinline__ float fast_rcp(float x) { return __builtin_amdgcn_rcpf(x); }
__device__ __forceinline__ float sigmoidf_(float x) { return fast_rcp(1.0f + __builtin_amdgcn_exp2f(-1.44269504089f * x)); }
__device__ __forceinline__ float siluf_(float x) { return x * sigmoidf_(x); }

namespace pg8 {
#define PG8_LAS __attribute__((address_space(3)))
constexpr int BM = 256, BK = 64, HALF = 128, HTB = HALF * BK * 2  , STAGE_BYTES = 8 * HTB, NXCD = 8, WGM = 8;

__host__ __device__ __forceinline__ int lds_byte(int r, int c) { const int st = (r >> 4) * 2 + (c >> 5), rr = r & 15, cc = c & 31, ob = rr * 64 + cc * 2; return st * 1024 + (ob ^ (((ob >> 9) & 1) << 5)); }
__host__ __device__ __forceinline__ void stage_rc(int b, int& R, int& C) { const int st = b / 1024, sb = b % 1024, swz = sb ^ (((sb >> 9) & 1) << 5); R = (st >> 1) * 16 + swz / 64; C = (st & 1) * 32 + (swz % 64) / 2; }
__host__ __device__ __forceinline__ int perm32(int rho) { const int n = rho >> 4, i = rho & 15; return 8 * (i >> 2) + 4 * n + (i & 3); }

struct Unit { int pm, pn; };
struct Gemm { const bf16_t* A; const bf16_t* Bt; int M, N, K; };

struct StaticOrder {
    int nM, nN, nwg, G, c;
    __host__ __device__ void init(int M, int N, int G_, int c_) { nM = M / BM; nN = N / BM; nwg = nM * nN; G = G_; c = c_; }
    __host__ __device__ bool next(int i, Unit& u) const {
        const long L = (long)i * G + c; if (L >= nwg) return false;
        int wgid = (int)L; { const int q = nwg / NXCD, r = nwg % NXCD, xcd = wgid % NXCD, off = wgid / NXCD; wgid = (xcd < r ? xcd * (q + 1) : r * (q + 1) + (xcd - r) * q) + off; }
        const int nig = WGM * nN, gid = wgid / nig, fm = gid * WGM, gsz = (nM - fm) < WGM ? (nM - fm) : WGM;
        u.pm = fm + ((wgid % nig) % gsz); u.pn = (wgid % nig) / gsz; return true;
    }
    __device__ __forceinline__ void a_ready(const Unit&) const {}
    __device__ __forceinline__ void done(const Unit&) const {}
};


struct EpiUp {
    static constexpr bool PERM = true, AFTER_DRAIN = false; static constexpr int MID_T = 0;
    bf16_t* H;
    __device__ __forceinline__ void operator()(const f32x4 (&acc)[2][2][4][2], const Unit& u, int wr, int wc, int fr, int fq) const {
        const int row0 = u.pm * BM + wr * 64 + fr, col0 = u.pn * HALF + wc * 32 + 8 * fq;
#pragma unroll
        for (int ai = 0; ai < 2; ++ai)
#pragma unroll
            for (int m = 0; m < 4; ++m) {
                const f32x4 a0 = acc[ai][0][m][0], a1 = acc[ai][0][m][1], b0 = acc[ai][1][m][0], b1 = acc[ai][1][m][1];
                u32x4 w;
                w.x = cvt_pk_bf16(siluf_(a0[0]) * b0[0], siluf_(a0[1]) * b0[1]); w.y = cvt_pk_bf16(siluf_(a0[2]) * b0[2], siluf_(a0[3]) * b0[3]);
                w.z = cvt_pk_bf16(siluf_(a1[0]) * b1[0], siluf_(a1[1]) * b1[1]); w.w = cvt_pk_bf16(siluf_(a1[2]) * b1[2], siluf_(a1[3]) * b1[3]);
                *(u32x4*)(H + (size_t)(row0 + ai * HALF + m * 16) * FF + col0) = w;
            }
    }
};
struct EpiResid {
    static constexpr bool PERM = false, AFTER_DRAIN = false; static constexpr int MID_T = 0;
    const float* base; float* out; const float* mod; int gate_idx; float gs;
    __device__ __forceinline__ void operator()(const f32x4 (&acc)[2][2][4][2], const Unit& u, int wr, int wc, int fr, int fq) const {
        const int row0 = u.pm * BM + wr * 64 + fr, col0 = u.pn * BM + wc * 32 + 4 * fq;
        const float* gp = mod + (size_t)(u.pm >> 4) * NADA + gate_idx * D + col0;
        f32x4 gv[2][2];
#pragma unroll
        for (int bj = 0; bj < 2; ++bj)
#pragma unroll
            for (int n = 0; n < 2; ++n) gv[bj][n] = *(const f32x4*)(gp + bj * HALF + n * 16) * gs;
#pragma unroll
        for (int ai = 0; ai < 2; ++ai)
#pragma unroll
            for (int m = 0; m < 4; ++m) { const size_t off = (size_t)(row0 + ai * HALF + m * 16) * D + col0;
#pragma unroll
                for (int bj = 0; bj < 2; ++bj)
#pragma unroll
                    for (int n = 0; n < 2; ++n) { const f32x4 bs = *(const f32x4*)(base + off + bj * HALF + n * 16); *(f32x4*)(out + off + bj * HALF + n * 16) = bs + gv[bj][n] * acc[ai][bj][m][n]; } }
    }
};
struct EpiProj {
    static constexpr bool PERM = true, AFTER_DRAIN = false; static constexpr int MID_T = 0;
    bf16_t *QKV, *U, *VB, *SA, *SB; float* out;
    __device__ __forceinline__ void operator()(const f32x4 (&acc)[2][2][4][2], const Unit& u, int wr, int wc, int fr, int fq) const {
        const int pn = u.pn, row0 = u.pm * BM + wr * 64 + fr, c8 = wc * 32 + 8 * fq;
        bf16_t* dst; int ld; bool sig = false;
        if (pn < 9) { dst = QKV + pn * BM; ld = 3 * DATT; }
        else if (pn < 11) { dst = U + (pn - 9) * BM; ld = DG; }
        else if (pn < 13) { dst = VB + (pn - 11) * BM; ld = DG; }
        else if (pn < 17) { dst = SA + (pn - 13) * BM; ld = D; sig = true; }
        else { dst = SB + (pn - 17) * BM; ld = D; sig = true; }
#pragma unroll
        for (int ai = 0; ai < 2; ++ai)
#pragma unroll
            for (int m = 0; m < 4; ++m) { bf16_t* rowp = dst + (size_t)(row0 + ai * HALF + m * 16) * ld + c8;
#pragma unroll
                for (int bj = 0; bj < 2; ++bj) { f32x4 v0 = acc[ai][bj][m][0], v1 = acc[ai][bj][m][1];
                    if (sig) {
#pragma unroll
                        for (int e = 0; e < 4; ++e) { v0[e] = sigmoidf_(v0[e]); v1[e] = sigmoidf_(v1[e]); } }
                    u32x4 w; w.x = cvt_pk_bf16(v0[0], v0[1]); w.y = cvt_pk_bf16(v0[2], v0[3]); w.z = cvt_pk_bf16(v1[0], v1[1]); w.w = cvt_pk_bf16(v1[2], v1[3]);
                    *(u32x4*)(rowp + bj * HALF) = w; } }
        if (pn >= 3 && pn < 9) {
            const int g = (pn - 3) % 3, isv = (pn >= 6) ? 1 : 0, win = 128 << (2 * g), b = u.pm >> 4, t0 = (u.pm & 15) * BM;
            if (t0 + BM > SEQ - win) {
                const size_t obase = (g == 0 ? O_KV0P : (g == 1 ? O_KV1P : O_KV2P)) + (size_t)b * win * 512 + isv * 256 + c8;
#pragma unroll
                for (int ai = 0; ai < 2; ++ai)
#pragma unroll
                    for (int m = 0; m < 4; ++m) { const int i = t0 + ai * HALF + wr * 64 + m * 16 + fr - (SEQ - win);
                        if (i >= 0) { float* p = out + obase + (size_t)i * 512;
#pragma unroll
                            for (int bj = 0; bj < 2; ++bj) { *(f32x4*)(p + bj * HALF) = acc[ai][bj][m][0]; *(f32x4*)(p + bj * HALF + 4) = acc[ai][bj][m][1]; } } }
            }
        }
    }
};
struct EpiMerge {
    static constexpr bool PERM = true, AFTER_DRAIN = false; static constexpr int MID_T = DATT / 64;
    const bf16_t *SA, *SB; bf16_t* MG;
    __device__ __forceinline__ void mid(f32x4 (&acc)[2][2][4][2], const Unit& u, int wr, int wc, int fr, int fq) const {
        int row0 = u.pm * BM + wr * 64 + fr; const int col0 = u.pn * BM + wc * 32 + 8 * fq;
        asm volatile("" : "+v"(row0));
#pragma unroll
        for (int ai = 0; ai < 2; ++ai)
#pragma unroll
            for (int m = 0; m < 4; ++m) { const size_t off = (size_t)(row0 + ai * HALF + m * 16) * D + col0;
#pragma unroll
                for (int bj = 0; bj < 2; ++bj) { const u32x4 a = *(const u32x4*)(SA + off + bj * HALF), b = *(const u32x4*)(SB + off + bj * HALF);
                    f32x4 r0, r1;
                    r0[0] = bflo(a.x) * fast_rcp(bflo(b.x)); r0[1] = bfhi(a.x) * fast_rcp(bfhi(b.x)); r0[2] = bflo(a.y) * fast_rcp(bflo(b.y)); r0[3] = bfhi(a.y) * fast_rcp(bfhi(b.y));
                    r1[0] = bflo(a.z) * fast_rcp(bflo(b.z)); r1[1] = bfhi(a.z) * fast_rcp(bfhi(b.z)); r1[2] = bflo(a.w) * fast_rcp(bflo(b.w)); r1[3] = bfhi(a.w) * fast_rcp(bfhi(b.w));
                    acc[ai][bj][m][0] *= r0; acc[ai][bj][m][1] *= r1; } }
    }
    __device__ __forceinline__ void operator()(const f32x4 (&acc)[2][2][4][2], const Unit& u, int wr, int wc, int fr, int fq) const {
        const int row0 = u.pm * BM + wr * 64 + fr, col0 = u.pn * BM + wc * 32 + 8 * fq;
#pragma unroll
        for (int ai = 0; ai < 2; ++ai)
#pragma unroll
            for (int m = 0; m < 4; ++m) { const size_t off = (size_t)(row0 + ai * HALF + m * 16) * D + col0;
#pragma unroll
                for (int bj = 0; bj < 2; ++bj) { const u32x4 b = *(const u32x4*)(SB + off + bj * HALF); const f32x4 v0 = acc[ai][bj][m][0], v1 = acc[ai][bj][m][1];
                    u32x4 w; w.x = cvt_pk_bf16(v0[0] * bflo(b.x), v0[1] * bfhi(b.x)); w.y = cvt_pk_bf16(v0[2] * bflo(b.y), v0[3] * bfhi(b.y));
                    w.z = cvt_pk_bf16(v1[0] * bflo(b.z), v1[1] * bfhi(b.z)); w.w = cvt_pk_bf16(v1[2] * bflo(b.w), v1[3] * bfhi(b.w));
                    *(u32x4*)(MG + off + bj * HALF) = w; } }
    }
};

template <class Epi, class Sched>
__device__ __forceinline__ void gemm_simple(const Gemm g, const Sched& S, const Epi& E) {
    const int tid = threadIdx.x, wid = __builtin_amdgcn_readfirstlane(tid >> 6), lane = tid & 63, wr = wid >> 2, wc = wid & 3, fr = lane & 15, fq = lane >> 4;
    const int K = g.K; Unit cur;
    for (int ui = 0; S.next(ui, cur); ++ui) {
        f32x4 acc[2][2][4][2];
#pragma unroll
        for (int a = 0; a < 2; ++a)
#pragma unroll
            for (int b = 0; b < 2; ++b)
#pragma unroll
                for (int m = 0; m < 4; ++m)
#pragma unroll
                    for (int n = 0; n < 2; ++n) acc[a][b][m][n] = (f32x4){0.f, 0.f, 0.f, 0.f};
        const bf16_t* ap = g.A + (size_t)(cur.pm * BM + wr * 64 + fr) * K + 8 * fq;
        const bf16_t* bp[2];
#pragma unroll
        for (int n = 0; n < 2; ++n) bp[n] = g.Bt + (size_t)(cur.pn * BM + wc * 32 + (Epi::PERM ? perm32(16 * n + fr) : 16 * n + fr)) * K + 8 * fq;
        for (int t = 0; t < K / 32; ++t) {
            if constexpr (Epi::MID_T > 0) { if (t == 2 * Epi::MID_T) E.mid(acc, cur, wr, wc, fr, fq); }
            bf16x8 Af[2][4], Bf[2][2];
#pragma unroll
            for (int ai = 0; ai < 2; ++ai)
#pragma unroll
                for (int m = 0; m < 4; ++m) Af[ai][m] = *(const bf16x8*)(ap + (size_t)(ai * HALF + m * 16) * K + t * 32);
#pragma unroll
            for (int bj = 0; bj < 2; ++bj)
#pragma unroll
                for (int n = 0; n < 2; ++n) Bf[bj][n] = *(const bf16x8*)(bp[n] + (size_t)(bj * HALF) * K + t * 32);
#pragma unroll
            for (int ai = 0; ai < 2; ++ai)
#pragma unroll
                for (int bj = 0; bj < 2; ++bj)
#pragma unroll
                    for (int m = 0; m < 4; ++m)
#pragma unroll
                        for (int n = 0; n < 2; ++n) acc[ai][bj][m][n] = __builtin_amdgcn_mfma_f32_16x16x32_bf16(Bf[bj][n], Af[ai][m], acc[ai][bj][m][n], 0, 0, 0);
        }
        E(acc, cur, wr, wc, fr, fq);
    }
}

template <class Epi, class Sched, bool ALIGN_EPI = false, bool SP2 = false>
__device__ __forceinline__ void gemm_phase(PG8_LAS unsigned char* lds, const Gemm g, const Sched& S, const Epi& E) {
    const int tid = threadIdx.x, wid = __builtin_amdgcn_readfirstlane(tid >> 6), lane = tid & 63, wr = wid >> 2, wc = wid & 3, fr = lane & 15, fq = lane >> 4;
    const int K = g.K, nt = K / BK;
    unsigned voffA[2], voffB[2];
#pragma unroll
    for (int i = 0; i < 2; ++i) { int R, C; stage_rc(tid * 16 + i * 8192, R, C); const int Rb = Epi::PERM ? ((R & ~31) + perm32(R & 31)) : R;
        voffA[i] = (unsigned)(R * K + C) * 2u; voffB[i] = (unsigned)(Rb * K + C) * 2u; }
    const size_t kstep = (size_t)(BK * 2);
    const size_t hstep = (size_t)HALF * K * 2;
    const size_t tstep = 2 * hstep;
    const unsigned ldsw = (unsigned)wid * 1024u;
    const int aoff = lds_byte(wr * 64 + fr, fq * 8), boff = lds_byte(wc * 32 + fr, fq * 8);
#define PG8_SA(b, h) (((b) * 2 + (h)) * HTB)
#define PG8_SB(b, h) ((4 + (b) * 2 + (h)) * HTB)
#define PG8_STAGE(bufoff, gbase, voff) do { _Pragma("unroll") for (int _i = 0; _i < 2; ++_i) \
        __builtin_amdgcn_global_load_lds((const unsigned*)((const char*)(gbase) + (voff)[_i]), (PG8_LAS unsigned*)(lds + (bufoff) + ldsw + _i * 8192), 16, 0, 0); } while (0)
#define PG8_LDA(dst, b, h) do { _Pragma("unroll") for (int m = 0; m < 4; ++m) _Pragma("unroll") for (int k = 0; k < 2; ++k) dst[m][k] = *(const PG8_LAS bf16x8*)(lds + PG8_SA(b, h) + aoff + m * 2048 + k * 1024); } while (0)
#define PG8_LDB(dst, b, h) do { _Pragma("unroll") for (int n = 0; n < 2; ++n) _Pragma("unroll") for (int k = 0; k < 2; ++k) dst[n][k] = *(const PG8_LAS bf16x8*)(lds + PG8_SB(b, h) + boff + n * 2048 + k * 1024); } while (0)
#define PG8_MMA(ai, bj, At, Bt) do { __builtin_amdgcn_s_setprio(1); _Pragma("unroll") for (int m = 0; m < 4; ++m) _Pragma("unroll") for (int n = 0; n < 2; ++n) _Pragma("unroll") for (int k = 0; k < 2; ++k) \
        acc[ai][bj][m][n] = __builtin_amdgcn_mfma_f32_16x16x32_bf16(Bt[n][k], At[m][k], acc[ai][bj][m][n], 0, 0, 0); __builtin_amdgcn_s_setprio(0); } while (0)
#define PG8_WAIT_V(n) asm volatile("s_waitcnt vmcnt(" #n ")" ::: "memory")
#define PG8_WAIT_L(n) asm volatile("s_waitcnt lgkmcnt(" #n ")" ::: "memory")
#define PG8_BAR __builtin_amdgcn_s_barrier()
#define PG8_SCHED __builtin_amdgcn_sched_barrier(0)
    Unit cur, nxt; int ui = 0;
    if (!S.next(0, cur)) return;
    f32x4 acc[2][2][4][2];
#pragma unroll
    for (int a = 0; a < 2; ++a)
#pragma unroll
        for (int b = 0; b < 2; ++b)
#pragma unroll
            for (int m = 0; m < 4; ++m)
#pragma unroll
                for (int n = 0; n < 2; ++n) acc[a][b][m][n] = (f32x4){0.f, 0.f, 0.f, 0.f};
    bf16x8 At[4][2], B0[2][2], B1[2][2];
    const char* cA = (const char*)g.A + (size_t)cur.pm * tstep; const char* cB = (const char*)g.Bt + (size_t)cur.pn * tstep;
    S.a_ready(cur);
    if constexpr (SP2) {
        PG8_STAGE(PG8_SB(0, 0), cB, voffB); PG8_STAGE(PG8_SB(0, 1), cB + hstep, voffB); PG8_STAGE(PG8_SA(0, 0), cA, voffA); PG8_STAGE(PG8_SA(0, 1), cA + hstep, voffA);
        if (wr == 1) PG8_BAR;
        PG8_WAIT_V(2); PG8_BAR;
        PG8_STAGE(PG8_SB(1, 0), cB + kstep, voffB); PG8_STAGE(PG8_SA(1, 0), cA + kstep, voffA); PG8_STAGE(PG8_SB(1, 1), cB + hstep + kstep, voffB);
        PG8_WAIT_V(6); PG8_BAR;
    } else {
        PG8_STAGE(PG8_SB(0, 0), cB, voffB); PG8_STAGE(PG8_SA(0, 0), cA, voffA); PG8_STAGE(PG8_SB(0, 1), cB + hstep, voffB); PG8_STAGE(PG8_SA(0, 1), cA + hstep, voffA);
        if (wr == 1) PG8_BAR;
        PG8_WAIT_V(4); PG8_BAR;
        PG8_STAGE(PG8_SB(1, 0), cB + kstep, voffB); PG8_STAGE(PG8_SA(1, 0), cA + kstep, voffA); PG8_STAGE(PG8_SB(1, 1), cB + hstep + kstep, voffB);
        PG8_WAIT_V(6); PG8_BAR;
    }
    for (;;) {
        const bool has_next = S.next(ui + 1, nxt);
        const char* nA = has_next ? (const char*)g.A + (size_t)nxt.pm * tstep : cA; const char* nB = has_next ? (const char*)g.Bt + (size_t)nxt.pn * tstep : cB;
        for (int t = 0; t < nt; t += 2) {
            const bool last = (t == nt - 2);
            if constexpr (Epi::MID_T > 0) { if (t == Epi::MID_T) E.mid(acc, cur, wr, wc, fr, fq); }
            const char* a1 = cA + (size_t)(t + 1) * kstep;
            const char* a2 = last ? nA : cA + (size_t)(t + 2) * kstep; const char* b2 = last ? nB : cB + (size_t)(t + 2) * kstep;
            const char* a3 = a2 + kstep; const char* b3 = b2 + kstep;
            if (last && has_next) S.a_ready(nxt);
            if constexpr (SP2) {
            PG8_LDB(B0, 0, 0); PG8_LDB(B1, 0, 1); PG8_SCHED; PG8_LDA(At, 0, 0); PG8_STAGE(PG8_SA(1, 1), a1 + hstep, voffA);
            PG8_WAIT_V(8); PG8_WAIT_L(0); PG8_BAR; PG8_MMA(0, 0, At, B0); PG8_MMA(0, 1, At, B1); PG8_BAR; PG8_SCHED;
            PG8_LDA(At, 0, 1); PG8_STAGE(PG8_SB(0, 0), b2, voffB); PG8_STAGE(PG8_SB(0, 1), b2 + hstep, voffB); PG8_STAGE(PG8_SA(0, 0), a2, voffA);
            PG8_WAIT_V(8); PG8_WAIT_L(0); PG8_BAR; PG8_MMA(1, 0, At, B0); PG8_MMA(1, 1, At, B1); PG8_BAR; PG8_SCHED;
            PG8_LDB(B0, 1, 0); PG8_LDB(B1, 1, 1); PG8_SCHED; PG8_LDA(At, 1, 0); PG8_STAGE(PG8_SA(0, 1), a2 + hstep, voffA);
            PG8_WAIT_V(8); PG8_WAIT_L(0); PG8_BAR; PG8_MMA(0, 0, At, B0); PG8_MMA(0, 1, At, B1); PG8_BAR; PG8_SCHED;
            PG8_LDA(At, 1, 1); PG8_STAGE(PG8_SB(1, 0), b3, voffB); PG8_STAGE(PG8_SB(1, 1), b3 + hstep, voffB); PG8_STAGE(PG8_SA(1, 0), a3, voffA);
            PG8_WAIT_V(8); PG8_WAIT_L(0); PG8_BAR; PG8_MMA(1, 0, At, B0); PG8_MMA(1, 1, At, B1); PG8_BAR; PG8_SCHED;
            } else {
            PG8_LDB(B0, 0, 0); PG8_SCHED; PG8_LDA(At, 0, 0); PG8_STAGE(PG8_SA(1, 1), a1 + hstep, voffA);
            PG8_WAIT_L(8); PG8_BAR; PG8_WAIT_L(0); PG8_MMA(0, 0, At, B0); PG8_BAR; PG8_SCHED;
            PG8_LDB(B1, 0, 1); PG8_STAGE(PG8_SB(0, 0), b2, voffB);
            PG8_BAR; PG8_WAIT_L(0); PG8_MMA(0, 1, At, B1); PG8_BAR;
            PG8_LDA(At, 0, 1); PG8_STAGE(PG8_SA(0, 0), a2, voffA);
            PG8_BAR; PG8_WAIT_L(0); PG8_MMA(1, 0, At, B0); PG8_BAR; PG8_SCHED;
            PG8_STAGE(PG8_SB(0, 1), b2 + hstep, voffB);
            PG8_WAIT_V(6); PG8_BAR; PG8_MMA(1, 1, At, B1); PG8_BAR;
            PG8_LDB(B0, 1, 0); PG8_SCHED; PG8_LDA(At, 1, 0); PG8_STAGE(PG8_SA(0, 1), a2 + hstep, voffA);
            PG8_WAIT_L(8); PG8_BAR; PG8_WAIT_L(0); PG8_MMA(0, 0, At, B0); PG8_BAR; PG8_SCHED;
            PG8_LDB(B1, 1, 1); PG8_STAGE(PG8_SB(1, 0), b3, voffB);
            PG8_BAR; PG8_WAIT_L(0); PG8_MMA(0, 1, At, B1); PG8_BAR;
            PG8_LDA(At, 1, 1); PG8_STAGE(PG8_SA(1, 0), a3, voffA);
            PG8_BAR; PG8_WAIT_L(0); PG8_MMA(1, 0, At, B0); PG8_BAR; PG8_SCHED;
            PG8_STAGE(PG8_SB(1, 1), b3 + hstep, voffB);
            PG8_WAIT_V(6); PG8_BAR; PG8_MMA(1, 1, At, B1); PG8_BAR;
            }
        }
        if constexpr (ALIGN_EPI) { if (wr == 0) PG8_BAR; }
        if constexpr (!Epi::AFTER_DRAIN) { E(acc, cur, wr, wc, fr, fq); S.done(cur); }
        if (!has_next) break;
#pragma unroll
        for (int a = 0; a < 2; ++a)
#pragma unroll
            for (int b = 0; b < 2; ++b)
#pragma unroll
                for (int m = 0; m < 4; ++m)
#pragma unroll
                    for (int n = 0; n < 2; ++n) acc[a][b][m][n] = (f32x4){0.f, 0.f, 0.f, 0.f};
        cur = nxt; cA = nA; cB = nB; ++ui;
        if constexpr (ALIGN_EPI) { if (wr == 1) PG8_BAR; }
    }
    PG8_WAIT_V(0);
    if constexpr (!ALIGN_EPI) { if (wr == 0) PG8_BAR; }
    PG8_BAR;
    if constexpr (Epi::AFTER_DRAIN) { E.fused(acc, cur, wr, wc, fr, fq, lds, wid, lane); S.done(cur); }
#undef PG8_SA
#undef PG8_SB
#undef PG8_STAGE
#undef PG8_LDA
#undef PG8_LDB
#undef PG8_MMA
#undef PG8_WAIT_V
#undef PG8_WAIT_L
#undef PG8_BAR
#undef PG8_SCHED
}
}

constexpr int NWAVES = 8;
constexpr int NPH = 15;
#ifndef MK_SEGS
#define MK_SEGS {0, NPH}
#endif
constexpr int SEGS[] = MK_SEGS;
constexpr int N_LAUNCHES = (int)(sizeof(SEGS) / sizeof(int)) / 2;
static_assert(N_LAUNCHES >= 1 && N_LAUNCHES <= 16, "1..16 launch segments");

constexpr size_t MiB = 1u << 20;
constexpr size_t WS_CTL = 0, CTL_ZERO_BYTES = 1 * MiB;
constexpr size_t WS_W1U = 2 * MiB, WS_W1D = 13 * MiB, WS_WIN = 19 * MiB, WS_WAB = 30 * MiB, WS_WO = 33 * MiB, WS_W2U = 35 * MiB, WS_W2D = 46 * MiB, WS_ADAW = 52 * MiB;
constexpr size_t WS_AADA = 70 * MiB;
constexpr size_t WS_MOD = 71 * MiB;
constexpr size_t WS_WSP = 77 * MiB;
constexpr size_t WS_XS = 78 * MiB;
constexpr size_t WS_PROJS = 79 * MiB;
constexpr size_t WS_LSE = 82 * MiB;
constexpr size_t WS_XN = 96 * MiB;
constexpr size_t WS_H = 226 * MiB;
constexpr size_t WS_QKV = 226 * MiB;
constexpr size_t WS_U = 514 * MiB;
constexpr size_t WS_VB = 580 * MiB;
constexpr size_t WS_SA = 644 * MiB, WS_SB = 772 * MiB;
constexpr size_t WS_AG = 900 * MiB;
constexpr size_t WS_MG = 1062 * MiB;
constexpr size_t WS_END = 1192 * MiB;
static_assert(WS_W1U + (size_t)2 * FF * D * 2 <= WS_W1D && WS_W1D + (size_t)D * FF * 2 <= WS_WIN && WS_WIN + (size_t)DIN * D * 2 <= WS_WAB && WS_WAB + (size_t)D * KAG * 2 <= WS_WO && WS_WO + (size_t)D * D * 2 <= WS_W2U, "ws map 1");
static_assert(WS_W2U + (size_t)2 * FF * D * 2 <= WS_W2D && WS_W2D + (size_t)D * FF * 2 <= WS_ADAW && WS_ADAW + (size_t)NADA * D * 2 <= WS_AADA && WS_MOD + (size_t)NMOD * NADA * 4 <= WS_WSP, "ws map 2");
static_assert(WS_PROJS + (size_t)DB * DIN * 4 <= WS_LSE && WS_LSE + (size_t)MP * 12 * 4 <= WS_XN && WS_XN + (size_t)MPAD * D * 2 <= WS_H && WS_H + (size_t)MPAD * FF * 2 <= WS_VB, "ws map 3");
static_assert(WS_QKV + (size_t)MP * 2304 * 2 <= WS_U && WS_U + (size_t)MP * DG * 2 <= WS_VB && WS_VB + (size_t)MP * DG * 2 <= WS_SA && WS_SA + (size_t)MP * D * 2 <= WS_SB && WS_SB + (size_t)MP * D * 2 <= WS_AG, "ws map 4");
static_assert(WS_AG + (size_t)MPAD * KAG * 2 <= WS_MG && WS_MG + (size_t)MPAD * D * 2 <= WS_END, "ws map 5");
constexpr int CW_BAR = 4096;

constexpr int RING_OFF = 0, RING_BYTES = 131072;
constexpr int LDSCTL_OFF = RING_BYTES, MISC_OFF = LDSCTL_OFF + 320;
constexpr int SMP_OFF = RING_BYTES + 1024;
constexpr int LDS_BYTES = 147456;
static_assert(MISC_OFF + 128 <= SMP_OFF && SMP_OFF + 10240 <= LDS_BYTES, "LDS map");

#define RLX_AGENT __ATOMIC_RELAXED, __HIP_MEMORY_SCOPE_AGENT
#define LDS_WAIT() asm volatile("s_waitcnt lgkmcnt(0)" ::: "memory")
#define VM_WAIT() asm volatile("s_waitcnt vmcnt(0)" ::: "memory")

#define XB_TMO      128
#define XB_XCNT(j)  (256  + 64 * (j))
#define XB_XSUB(j)  (1280 + 64 * (j))
#define XB_XGEN(j)  (2304 + 64 * (j))
#define XB_TOP      3328
#define XB_TOPGEN   3392
#define XCD_BAR_WORDS 3456
#define XB_SPIN_CAP (1u << 18)

__device__ __forceinline__ unsigned xb_ld(unsigned* p)              { return __hip_atomic_load(p, __ATOMIC_RELAXED, __HIP_MEMORY_SCOPE_AGENT); }
__device__ __forceinline__ unsigned xb_add(unsigned* p, unsigned v) { return __hip_atomic_fetch_add(p, v, __ATOMIC_RELAXED, __HIP_MEMORY_SCOPE_AGENT); }
__device__ __forceinline__ unsigned xb_xcc_id() { return (unsigned)__builtin_amdgcn_s_getreg((3 << 11) | 20) & 0xFu; }
#define XB_SPIN(cond, bar) do { unsigned _sp = 0; while (cond) { __builtin_amdgcn_s_sleep(1); \
    if ((++_sp & 255u) == 0u) { if (xb_ld(&(bar)[XB_TMO])) break; if (_sp > XB_SPIN_CAP) { atomicAdd(&(bar)[XB_TMO], 1u); break; } } } } while (0)

struct XcdBarrier {
    unsigned* bar; unsigned x;
    volatile LAS unsigned* st;
};

__device__ __forceinline__ XcdBarrier xcd_barrier_post(unsigned* bar, volatile LAS unsigned* st) {
    XcdBarrier b; b.bar = bar; b.x = xb_xcc_id(); b.st = st;
    if (threadIdx.x == 0) (void)xb_add(&bar[XB_XCNT(b.x)], 1u);
    return b;
}
__device__ __forceinline__ void xcd_barrier_complete(unsigned* bar, unsigned x, unsigned& nloc, unsigned& nx) {
    const unsigned G = gridDim.x * gridDim.y * gridDim.z;
    unsigned sum, cnt, mine, sp = 0u;
    for (;;) {
        sum = 0u; cnt = 0u; mine = 0u;
#pragma unroll
        for (unsigned j = 0; j < 16; ++j) { const unsigned c = xb_ld(&bar[XB_XCNT(j)]); sum += c; cnt += (c > 0u) ? 1u : 0u; mine = (j == x) ? c : mine; }
        if (sum == G) break;
        __builtin_amdgcn_s_sleep(1);
        if ((++sp & 255u) == 0u) { if (xb_ld(&bar[XB_TMO])) break; if (sp > XB_SPIN_CAP) { atomicAdd(&bar[XB_TMO], 1u); break; } }
    }
    nloc = mine > 0u ? mine : 1u; nx = cnt > 0u ? cnt : 1u;
}

__device__ __forceinline__ void xcd_barrier(const XcdBarrier& b) {
    asm volatile("s_waitcnt vmcnt(0)" ::: "memory");
    __syncthreads();
    if (threadIdx.x == 0) {
        unsigned* bar = b.bar;
        __builtin_amdgcn_s_waitcnt(0);
        unsigned nloc = b.st[0], nx = b.st[1];
        if (nloc == 0u) { xcd_barrier_complete(bar, b.x, nloc, nx); b.st[0] = nloc; b.st[1] = nx; }
        const unsigned old = xb_add(&bar[XB_XSUB(b.x)], 1u);
        const unsigned gen = old / nloc;
        if (old + 1u == (gen + 1u) * nloc) {
            __builtin_amdgcn_fence(__ATOMIC_RELEASE, "agent");
            asm volatile("s_waitcnt vmcnt(0)" ::: "memory");
            const unsigned og = xb_add(&bar[XB_TOP], 1u);
            const unsigned tg = og / nx;
            if (og + 1u == (tg + 1u) * nx) xb_add(&bar[XB_TOPGEN], 1u);
            else XB_SPIN(xb_ld(&bar[XB_TOPGEN]) == tg, bar);
            __builtin_amdgcn_fence(__ATOMIC_ACQUIRE, "agent");
            xb_add(&bar[XB_XGEN(b.x)], 1u);
            asm volatile("s_waitcnt vmcnt(0)" ::: "memory");
        } else {
            XB_SPIN(xb_ld(&bar[XB_XGEN(b.x)]) == gen, bar);
            __builtin_amdgcn_fence(__ATOMIC_ACQUIRE, "agent");
            asm volatile("s_waitcnt vmcnt(0)" ::: "memory");
        }
    }
    __syncthreads();
}

__device__ __forceinline__ float wave_sum(float v) {
#pragma unroll
    for (int o = 1; o < 64; o <<= 1) v += __shfl_xor(v, o);
    return v;
}
__device__ __forceinline__ float wave_max(float v) {
#pragma unroll
    for (int o = 1; o < 64; o <<= 1) v = fmaxf(v, __shfl_xor(v, o));
    return v;
}
__device__ __forceinline__ unsigned offb(unsigned row, unsigned ch) { return 256u * row + 16u * (ch ^ (((row & 3u) << 2) | ((row >> 2) & 3u))); }
typedef short v4i16_t __attribute__((ext_vector_type(4)));
__device__ __forceinline__ s16x4 tr_read(LAS unsigned char* p) { return __builtin_bit_cast(s16x4, __builtin_amdgcn_ds_read_tr16_b64_v4i16((LAS v4i16_t*)p)); }
__device__ __forceinline__ int crow(int reg, int h) { return (reg & 3) + 8 * (reg >> 2) + 4 * h; }
#define MFMA32(a, b, c) __builtin_amdgcn_mfma_f32_32x32x16_bf16((a), (b), (c), 0, 0, 0)
#define MFMA16(a, b, c) __builtin_amdgcn_mfma_f32_16x16x32_bf16((a), (b), (c), 0, 0, 0)

struct Args { const float* in[23]; float* out; unsigned char* ws; int ph_lo, ph_hi, li, pad; };

__device__ __forceinline__ void p0_transpose_item(const float* W, int K, int N, bf16_t* WT, int ldt, int koff, int mode, LAS float* scr, int item, int lane) {
    const int nblk = N / 32, kb = item / nblk, nb = item % nblk, k0 = 64 * kb, n0 = 32 * nb;
#pragma unroll 8
    for (int i = 0; i < 32; ++i) { const int kk = 2 * i + (lane >> 5); scr[kk * 33 + (lane & 31)] = W[(size_t)(k0 + kk) * N + n0 + (lane & 31)]; }
    LDS_WAIT(); asm volatile("" ::: "memory");
    int rbase = n0;
    if (mode == 1) { const int j = n0 >= FF ? n0 - FF : n0; rbase = 256 * (j >> 7) + (j & 127) + (n0 >= FF ? 128 : 0); }
    const int c = lane & 7;
#pragma unroll
    for (int j = 0; j < 4; ++j) { const int n = (lane >> 3) + 8 * j; const LAS float* s = scr + (8 * c) * 33 + n;
        u32x4 o; o.x = cvt_pk_bf16(s[0 * 33], s[1 * 33]); o.y = cvt_pk_bf16(s[2 * 33], s[3 * 33]); o.z = cvt_pk_bf16(s[4 * 33], s[5 * 33]); o.w = cvt_pk_bf16(s[6 * 33], s[7 * 33]);
        *(u32x4*)(WT + (size_t)(rbase + n) * ldt + koff + k0 + 8 * c) = o; }
    LDS_WAIT(); asm volatile("" ::: "memory");
}
__device__ __forceinline__ void kv_copy(const float* cache, float* outp, int L, size_t gt, size_t NT) {
    const size_t n4 = (size_t)DB * L * 128;
    const f32x4* src = (const f32x4*)cache + 128; f32x4* dst = (f32x4*)outp;
    for (size_t i = gt; i < n4; i += 4 * NT) {
        f32x4 v[4]; bool ok[4];
#pragma unroll
        for (int j = 0; j < 4; ++j) { const size_t k = i + j * NT; ok[j] = k < n4 && (int)((k >> 7) % (size_t)L) != L - 1; if (ok[j]) v[j] = __builtin_nontemporal_load(src + k); }
#pragma unroll
        for (int j = 0; j < 4; ++j) { const size_t k = i + j * NT; if (ok[j]) __builtin_nontemporal_store(v[j], dst + k); }
    }
}

template <int NBF>
__device__ __forceinline__ void skinny_dot(f32x4 (&acc)[NBF], const bf16_t* ap, const bf16_t* bp0, const bf16_t* bp1, int nsteps) {
    for (int s = 0; s < nsteps; s += 8) {
        bf16x8 a[8], b0[8], b1[8];
#pragma unroll
        for (int j = 0; j < 8; ++j) { a[j] = *(const bf16x8*)(ap + (s + j) * 32); b0[j] = *(const bf16x8*)(bp0 + (s + j) * 32); if (NBF > 1) b1[j] = *(const bf16x8*)(bp1 + (s + j) * 32); }
#pragma unroll
        for (int j = 0; j < 8; ++j) { acc[0] = MFMA16(b0[j], a[j], acc[0]); if (NBF > 1) acc[1] = MFMA16(b1[j], a[j], acc[1]); }
    }
}

__device__ __forceinline__ void norm_mod_rows(const float* X, const float* XSmp, const float* gain, const float* mod, int idx, bf16_t* XN, int gw, int NGW, int lane) {
    for (int blk = gw; blk < MP / 32 + DB; blk += NGW) {
        const bool smp = blk >= MP / 32;
        const int b = smp ? NB + (blk - MP / 32) : (blk >> 7);
        const float* mp = mod + (size_t)b * NADA + (3 * idx) * D;
        f32x4 ca[4], cs[4];
#pragma unroll
        for (int j = 0; j < 4; ++j) { const int col = 4 * lane + 256 * j; const f32x4 gg = *(const f32x4*)(gain + col), sc = *(const f32x4*)(mp + D + col); ca[j] = gg * (sc + 1.0f); cs[j] = *(const f32x4*)(mp + col); }
        const int nrows = smp ? 1 : 32;
        const float* src = smp ? XSmp + (size_t)(blk - MP / 32) * D : X + (size_t)blk * 32 * D;
        bf16_t* dst = XN + (smp ? (size_t)(MP + blk - MP / 32) : (size_t)blk * 32) * D;
        for (int rr = 0; rr < nrows; ++rr) {
            f32x4 v[4]; float ss = 0.f;
#pragma unroll
            for (int j = 0; j < 4; ++j) { v[j] = *(const f32x4*)(src + (size_t)rr * D + 4 * lane + 256 * j); ss += (v[j][0] * v[j][0] + v[j][1] * v[j][1]) + (v[j][2] * v[j][2] + v[j][3] * v[j][3]); }
            const float r = __builtin_amdgcn_rsqf(wave_sum(ss) * (1.0f / D) + EPS);
#pragma unroll
            for (int j = 0; j < 4; ++j) { const f32x4 o = v[j] * r * ca[j] + cs[j]; u32x2 w; w.x = cvt_pk_bf16(o[0], o[1]); w.y = cvt_pk_bf16(o[2], o[3]); *(u32x2*)(dst + (size_t)rr * D + 4 * lane + 256 * j) = w; }
        }
    }
}
__device__ __forceinline__ void final_norm_rows(float* Y, const float* XSmp, float* YS, const float* gain, int gw, int NGW, int lane) {
    f32x4 cg[4];
#pragma unroll
    for (int j = 0; j < 4; ++j) cg[j] = *(const f32x4*)(gain + 4 * lane + 256 * j);
    for (int blk = gw; blk < MP / 32 + DB; blk += NGW) {
        const bool smp = blk >= MP / 32;
        const int nrows = smp ? 1 : 32;
        const float* src = smp ? XSmp + (size_t)(blk - MP / 32) * D : Y + (size_t)blk * 32 * D;
        float* dst = smp ? YS + (size_t)(blk - MP / 32) * D : Y + (size_t)blk * 32 * D;
        for (int rr = 0; rr < nrows; ++rr) {
            f32x4 v[4]; float ss = 0.f;
#pragma unroll
            for (int j = 0; j < 4; ++j) { v[j] = *(const f32x4*)(src + (size_t)rr * D + 4 * lane + 256 * j); ss += (v[j][0] * v[j][0] + v[j][1] * v[j][1]) + (v[j][2] * v[j][2] + v[j][3] * v[j][3]); }
            const float r = __builtin_amdgcn_rsqf(wave_sum(ss) * (1.0f / D) + EPS);
#pragma unroll
            for (int j = 0; j < 4; ++j) *(f32x4*)(dst + (size_t)rr * D + 4 * lane + 256 * j) = v[j] * r * cg[j];
        }
    }
}

struct AttnUnit { int hp, g, b, dsh, r, n, head0; size_t tok0; };
__device__ __forceinline__ AttnUnit attn_decode(int unit) {
    AttnUnit a; a.hp = unit & 1; const int rn = (unit >> 1) & 31, gb = unit >> 6; a.g = gb % 3; a.b = gb / 3;
    a.dsh = 2 * a.g; const int dil = 1 << a.dsh; a.r = rn & (dil - 1); a.n = rn >> a.dsh; a.tok0 = (size_t)a.b * SEQ + a.r; a.head0 = 4 * a.g + 2 * a.hp; return a;
}
__device__ __forceinline__ void attn_load(const bf16_t* QKV, int unit, int tid, u32x4 (&kreg)[8], u32x4 (&vreg)[8]) {
    const AttnUnit a = attn_decode(unit);
    const int jj_lo = (a.n == 0) ? 128 : 0;
#pragma unroll
    for (int it = 0; it < 8; ++it) {
        const int cid = it * 512 + tid, row = cid >> 4, ch = cid & 15;
        if (row >= jj_lo) {
            const size_t tok = a.tok0 + ((size_t)((a.n - 1) * 128 + row) << a.dsh);
            const bf16_t* src = QKV + tok * 2304 + a.head0 * 64 + ch * 8;
            kreg[it] = *(const u32x4*)(src + DATT); vreg[it] = *(const u32x4*)(src + 2 * DATT);
        }
    }
}
__device__ __forceinline__ void attn_load_q(const bf16_t* QKV, int unit, int wave, int lane, bf16x8 (&qf)[4]) {
    const AttnUnit a = attn_decode(unit);
    const int hsel = wave >> 2, qsub = wave & 3, ql = lane & 31, h = lane >> 5;
    const size_t tokq = a.tok0 + ((size_t)(a.n * 128 + 32 * qsub + ql) << a.dsh);
    const bf16_t* qp = QKV + tokq * 2304 + (a.head0 + hsel) * 64 + 8 * h;
#pragma unroll
    for (int dc = 0; dc < 4; ++dc) qf[dc] = *(const bf16x8*)(qp + 16 * dc);
}
__device__ __forceinline__ void attn_write(LAS unsigned char* lds, int unit, int tid, const u32x4 (&kreg)[8], const u32x4 (&vreg)[8]) {
    const AttnUnit a = attn_decode(unit);
    const int jj_lo = (a.n == 0) ? 128 : 0;
    LAS unsigned char* Kimg = lds; LAS unsigned char* Vimg = lds + 65536;
#pragma unroll
    for (int it = 0; it < 8; ++it) {
        const int cid = it * 512 + tid, row = cid >> 4, ch = cid & 15;
        if (row >= jj_lo) { *(LAS u32x4*)(Kimg + offb(row, ch)) = kreg[it]; *(LAS u32x4*)(Vimg + offb(row, ch)) = vreg[it]; }
    }
}
__device__ __forceinline__ void attn_compute(LAS unsigned char* lds, bf16_t* AG, float* LSE, int unit, int wave, int lane, const bf16x8 (&qf)[4]) {
    const AttnUnit a = attn_decode(unit);
    const int n = a.n;
    LAS unsigned char* Kimg = lds; LAS unsigned char* Vimg = lds + 65536;
    const int hsel = wave >> 2, qsub = wave & 3, ql = lane & 31, h = lane >> 5;
    const int q4 = (lane & 15) >> 2, p4 = lane & 3, blk = (lane >> 4) & 1;
    const size_t tokq = a.tok0 + ((size_t)(n * 128 + 32 * qsub + ql) << a.dsh);
    const float cs = 0.125f * 1.44269504089f;
    f32x16 o0, o1;
#pragma unroll
    for (int i = 0; i < 16; ++i) { o0[i] = 0.f; o1[i] = 0.f; }
    float m = -INFINITY, l = 0.f;
#pragma unroll
    for (int tt = 0; tt < 5; ++tt) {
        const int jt = qsub + tt;
        if (!(n == 0 && jt < 4)) {
            f32x16 s;
#pragma unroll
            for (int i = 0; i < 16; ++i) s[i] = 0.f;
#pragma unroll
            for (int dc = 0; dc < 4; ++dc) { const bf16x8 kf = *(const LAS bf16x8*)(Kimg + offb(32 * jt + ql, hsel * 8 + 2 * dc + h)); s = MFMA32(kf, qf[dc], s); }
            float tm = -INFINITY;
#pragma unroll
            for (int i = 0; i < 16; ++i) { const int kr = crow(i, h); bool ok = true; if (tt == 0) ok = (kr >= ql); if (tt == 4) ok = (kr <= ql); s[i] = ok ? s[i] : -INFINITY; tm = fmaxf(tm, s[i]); }
            tm = fmaxf(tm, __shfl_xor(tm, 32));
            const float mn = fmaxf(m, tm), alpha = __builtin_amdgcn_exp2f((m - mn) * cs), mc = mn * cs;
            m = mn;
            float ps = 0.f;
#pragma unroll
            for (int i = 0; i < 16; ++i) { const float p = __builtin_amdgcn_exp2f(s[i] * cs - mc); s[i] = p; ps += p; }
            l = l * alpha + ps;
#pragma unroll
            for (int i = 0; i < 16; ++i) { o0[i] *= alpha; o1[i] *= alpha; }
#pragma unroll
            for (int ks = 0; ks < 2; ++ks) {
                u32x4 pw;
                pw.x = cvt_pk_bf16(s[8 * ks + 0], s[8 * ks + 1]); pw.y = cvt_pk_bf16(s[8 * ks + 2], s[8 * ks + 3]);
                pw.z = cvt_pk_bf16(s[8 * ks + 4], s[8 * ks + 5]); pw.w = cvt_pk_bf16(s[8 * ks + 6], s[8 * ks + 7]);
                const bf16x8 pf = __builtin_bit_cast(bf16x8, pw);
                const int row0 = 32 * jt + 16 * ks + 4 * h + q4;
#pragma unroll
                for (int c = 0; c < 2; ++c) {
                    const int chv = hsel * 8 + 4 * c + 2 * blk + (p4 >> 1);
                    const s16x4 lo = tr_read(Vimg + offb(row0, chv) + 8 * (p4 & 1)), hi = tr_read(Vimg + offb(row0 + 8, chv) + 8 * (p4 & 1));
                    const bf16x8 vf = __builtin_shufflevector(lo, hi, 0, 1, 2, 3, 4, 5, 6, 7);
                    if (c == 0) o0 = MFMA32(vf, pf, o0); else o1 = MFMA32(vf, pf, o1);
                }
            }
        }
    }
    l += __shfl_xor(l, 32);
    const float inv = 1.0f / l;
    bf16_t* op = AG + tokq * KAG + (a.head0 + hsel) * 64 + 4 * h;
#pragma unroll
    for (int gq = 0; gq < 4; ++gq) {
        u32x2 w0, w1;
        w0.x = cvt_pk_bf16(o0[4 * gq] * inv, o0[4 * gq + 1] * inv); w0.y = cvt_pk_bf16(o0[4 * gq + 2] * inv, o0[4 * gq + 3] * inv);
        w1.x = cvt_pk_bf16(o1[4 * gq] * inv, o1[4 * gq + 1] * inv); w1.y = cvt_pk_bf16(o1[4 * gq + 2] * inv, o1[4 * gq + 3] * inv);
        *(u32x2*)(op + 8 * gq) = w0; *(u32x2*)(op + 32 + 8 * gq) = w1;
    }
    if (h == 0) LSE[tokq * 12 + a.head0 + hsel] = m * 0.125f + __logf(l);
}
__device__ __forceinline__ void attn_prompt_phase(LAS unsigned char* lds, const bf16_t* QKV, bf16_t* AG, float* LSE, int vcu, int G, int tid, int wave, int lane) {
    constexpr int NU = NB * 3 * 32 * 2;
    u32x4 kreg[8], vreg[8]; bf16x8 qn[4], qc[4];
    int u = vcu;
    if (u < NU) { attn_load(QKV, u, tid, kreg, vreg); attn_load_q(QKV, u, wave, lane, qn); }
    while (u < NU) {
        attn_write(lds, u, tid, kreg, vreg);
#pragma unroll
        for (int dc = 0; dc < 4; ++dc) qc[dc] = qn[dc];
        __syncthreads();
        const int un = u + G;
        if (un < NU) { attn_load(QKV, un, tid, kreg, vreg); attn_load_q(QKV, un, wave, lane, qn); }
        attn_compute(lds, AG, LSE, u, wave, lane, qc);
        __syncthreads();
        u = un;
    }
}

__device__ __forceinline__ void gmlp_phase(LAS unsigned char* lds, const bf16_t* VB, const bf16_t* U, const bf16_t* WSP, const float* bsp, const float* lng, const float* lnb, bf16_t* AG, float* out,
                                           int vcu, int G, int wave, int lane) {
    const int grp = wave >> 1, ql = lane & 31, h = lane >> 5, q4 = (lane & 15) >> 2, p4 = lane & 3, blk = (lane >> 4) & 1;
    bf16x8 bw[20];
    {
        const bf16_t* wg = WSP + (size_t)grp * 128 * 128 + 8 * h;
        int idx = 0;
#pragma unroll
        for (int s = 0; s < 8; ++s)
#pragma unroll
            for (int it = s >> 1; it < 4; ++it) { bw[idx] = *(const bf16x8*)(wg + (size_t)(32 * it + ql) * 128 + 16 * s); ++idx; }
    }
    const f32x4 g0 = *(const f32x4*)(lng + 8 * lane), g1 = *(const f32x4*)(lng + 8 * lane + 4), b0 = *(const f32x4*)(lnb + 8 * lane), b1 = *(const f32x4*)(lnb + 8 * lane + 4);
    for (int unit = vcu; unit < NB * 32; unit += G) {
        const int b = unit >> 5, c = unit & 31;
        const size_t tokb = (size_t)b * SEQ + c * 128;
        {
            LAS unsigned char* img = lds + (lane >> 4) * 32768;
            u32x4 xr[16];
#pragma unroll
            for (int jr = 0; jr < 16; ++jr) xr[jr] = *(const u32x4*)(VB + (tokb + 16 * wave + jr) * DG + 8 * lane);
#pragma unroll
            for (int jr = 0; jr < 16; ++jr) {
                const int j = 16 * wave + jr; const u32x4 x = xr[jr];
                f32x4 v0, v1; v0[0] = bflo(x.x); v0[1] = bfhi(x.x); v0[2] = bflo(x.y); v0[3] = bfhi(x.y); v1[0] = bflo(x.z); v1[1] = bfhi(x.z); v1[2] = bflo(x.w); v1[3] = bfhi(x.w);
                const float mean = wave_sum((v0[0] + v0[1]) + (v0[2] + v0[3]) + (v1[0] + v1[1]) + (v1[2] + v1[3])) * (1.0f / DG);
                v0 = v0 - mean; v1 = v1 - mean;
                const float var = wave_sum((v0[0] * v0[0] + v0[1] * v0[1]) + (v0[2] * v0[2] + v0[3] * v0[3]) + (v1[0] * v1[0] + v1[1] * v1[1]) + (v1[2] * v1[2] + v1[3] * v1[3])) * (1.0f / DG);
                const float rstd = __builtin_amdgcn_rsqf(var + EPS);
                v0 = v0 * rstd * g0 + b0; v1 = v1 * rstd * g1 + b1;
                if (c == 31) { float* vo = out + O_VRP + ((size_t)b * 128 + j) * DG + 8 * lane; *(f32x4*)vo = v0; *(f32x4*)(vo + 4) = v1; }
                u32x4 w; w.x = cvt_pk_bf16(v0[0], v0[1]); w.y = cvt_pk_bf16(v0[2], v0[3]); w.z = cvt_pk_bf16(v1[0], v1[1]); w.w = cvt_pk_bf16(v1[2], v1[3]);
                *(LAS u32x4*)(img + offb(j, lane & 15)) = w;
            }
        }
        __syncthreads();
        LAS unsigned char* img = lds + grp * 32768;
#pragma unroll 1
        for (int cc = 0; cc < 2; ++cc) {
            const int c32 = (wave & 1) * 2 + cc;
            f32x16 acc[4];
#pragma unroll
            for (int it = 0; it < 4; ++it)
#pragma unroll
                for (int i = 0; i < 16; ++i) acc[it][i] = 0.f;
            const int chv = 4 * c32 + 2 * blk + (p4 >> 1);
            int idx = 0;
#pragma unroll
            for (int s = 0; s < 8; ++s) {
                const int row0 = 16 * s + 8 * h + q4;
                const s16x4 lo = tr_read(img + offb(row0, chv) + 8 * (p4 & 1)), hi = tr_read(img + offb(row0 + 4, chv) + 8 * (p4 & 1));
                const bf16x8 af = __builtin_shufflevector(lo, hi, 0, 1, 2, 3, 4, 5, 6, 7);
#pragma unroll
                for (int it = s >> 1; it < 4; ++it) { acc[it] = MFMA32(af, bw[idx], acc[it]); ++idx; }
            }
#pragma unroll
            for (int it = 0; it < 4; ++it) {
                const int i = 32 * it + ql; const float bias = bsp[grp * 128 + i];
                const size_t tok = tokb + i;
                const bf16_t* up = U + tok * DG + grp * 128 + 32 * c32 + 4 * h;
                bf16_t* gp = AG + tok * KAG + DATT + grp * 128 + 32 * c32 + 4 * h;
#pragma unroll
                for (int gq = 0; gq < 4; ++gq) { const u32x2 uu = *(const u32x2*)(up + 8 * gq);
                    u32x2 w; w.x = cvt_pk_bf16(bflo(uu.x) * (acc[it][4 * gq] + bias), bfhi(uu.x) * (acc[it][4 * gq + 1] + bias)); w.y = cvt_pk_bf16(bflo(uu.y) * (acc[it][4 * gq + 2] + bias), bfhi(uu.y) * (acc[it][4 * gq + 3] + bias));
                    *(u32x2*)(gp + 8 * gq) = w; }
            }
        }
        __syncthreads();
    }
}

__device__ __forceinline__ void sample_unit(LAS unsigned char* lds, const float* PROJS, const float* c0, const float* c1, const float* c2, const float* wsp, const float* bsp, const float* lng, const float* lnb,
                                            bf16_t* AG, float* out, int b, int tid, int wave, int lane) {
    LAS float* qs = (LAS float*)(lds + SMP_OFF) + wave * 64;
    LAS float* ps = (LAS float*)(lds + SMP_OFF + 2048) + wave * 128;
    LAS float* osh = (LAS float*)(lds + SMP_OFF + 6144);
    LAS float* lsv = (LAS float*)(lds + SMP_OFF + 9216);
    const float* pr = PROJS + (size_t)b * DIN;
#pragma unroll 1
    for (int head = wave; head < 12; head += 8) {
        const int g = head >> 2, hh = head & 3, dsh = 2 * g, L = 128 << dsh;
        const float* cg = (g == 0 ? c0 : (g == 1 ? c1 : c2)) + (size_t)b * L * 512;
        const float qv = pr[head * 64 + lane];
        qs[lane] = qv;
        LDS_WAIT(); asm volatile("" ::: "memory");
        float sc[2];
#pragma unroll
        for (int kk = 0; kk < 2; ++kk) {
            const float* kp = cg + ((size_t)(lane + 64 * kk) << dsh) * 512 + hh * 64;
            float d = 0.f;
#pragma unroll
            for (int j = 0; j < 16; ++j) { const f32x4 kv = *(const f32x4*)(kp + 4 * j); const f32x4 q4v = *(const LAS f32x4*)(qs + 4 * j); d += (kv[0] * q4v[0] + kv[1] * q4v[1]) + (kv[2] * q4v[2] + kv[3] * q4v[3]); }
            sc[kk] = d * 0.125f;
        }
        const float snew = wave_sum(qv * pr[DATT + head * 64 + lane]) * 0.125f;
        const float mx = wave_max(fmaxf(fmaxf(sc[0], sc[1]), snew));
        const float p0 = __expf(sc[0] - mx), p1 = __expf(sc[1] - mx), pn = __expf(snew - mx);
        const float l = wave_sum(p0 + p1) + pn;
        ps[lane] = p0; ps[lane + 64] = p1;
        LDS_WAIT(); asm volatile("" ::: "memory");
        {
            const int ks = lane >> 4, dq = lane & 15;
            const float* vp = cg + 256 + hh * 64 + 4 * dq;
            f32x4 o4 = (f32x4){0.f, 0.f, 0.f, 0.f};
            if (ks == 0) o4 = *(const f32x4*)(pr + 2 * DATT + head * 64 + 4 * dq) * pn;
#pragma unroll 8
            for (int it = 0; it < 32; ++it) { const int m = 4 * it + ks; o4 += *(const f32x4*)(vp + ((size_t)m << dsh) * 512) * ps[m]; }
#pragma unroll
            for (int e = 0; e < 4; ++e) { float t = o4[e]; t += __shfl_xor(t, 16); t += __shfl_xor(t, 32); o4[e] = t; }
            if (ks == 0) *(LAS f32x4*)(osh + head * 64 + 4 * dq) = o4 * (1.0f / l);
        }
        if (lane == 0) lsv[head] = mx + __logf(l);
        LDS_WAIT(); asm volatile("" ::: "memory");
    }
    __syncthreads();
    for (int t = tid; t < DATT; t += NWAVES * 64) {
        const int head = t >> 6, hh = head & 3, g = head >> 2;
        const float l0 = lsv[hh], l1 = lsv[4 + hh], l2 = lsv[8 + hh], m = fmaxf(l0, fmaxf(l1, l2));
        const float e0 = __expf(l0 - m), e1 = __expf(l1 - m), e2 = __expf(l2 - m);
        const float w = (g == 0 ? e0 : (g == 1 ? e1 : e2)) / (e0 + e1 + e2);
        AG[(size_t)(MP + b) * KAG + t] = (bf16_t)(cvt_pk_bf16(osh[t] * w, 0.f) & 0xffffu);
    }
    if (wave == 4) {
        const int grp = lane >> 4;
        f32x4 v0 = *(const f32x4*)(pr + 2816 + 8 * lane), v1 = *(const f32x4*)(pr + 2816 + 8 * lane + 4);
        const float mean = wave_sum((v0[0] + v0[1]) + (v0[2] + v0[3]) + (v1[0] + v1[1]) + (v1[2] + v1[3])) * (1.0f / DG);
        v0 = v0 - mean; v1 = v1 - mean;
        const float var = wave_sum((v0[0] * v0[0] + v0[1] * v0[1]) + (v0[2] * v0[2] + v0[3] * v0[3]) + (v1[0] * v1[0] + v1[1] * v1[1]) + (v1[2] * v1[2] + v1[3] * v1[3])) * (1.0f / DG);
        const float rstd = __builtin_amdgcn_rsqf(var + EPS);
        v0 = v0 * rstd * *(const f32x4*)(lng + 8 * lane) + *(const f32x4*)(lnb + 8 * lane); v1 = v1 * rstd * *(const f32x4*)(lng + 8 * lane + 4) + *(const f32x4*)(lnb + 8 * lane + 4);
        float* vo = out + O_VRS + (size_t)b * DG + 8 * lane; *(f32x4*)vo = v0; *(f32x4*)(vo + 4) = v1;
        const float w00 = wsp[(size_t)grp * 128 * 128], b00 = bsp[grp * 128];
        const f32x4 u0 = *(const f32x4*)(pr + 2304 + 8 * lane), u1 = *(const f32x4*)(pr + 2304 + 8 * lane + 4);
        const f32x4 m0 = u0 * (v0 * w00 + b00), m1 = u1 * (v1 * w00 + b00);
        u32x4 w; w.x = cvt_pk_bf16(m0[0], m0[1]); w.y = cvt_pk_bf16(m0[2], m0[3]); w.z = cvt_pk_bf16(m1[0], m1[1]); w.w = cvt_pk_bf16(m1[2], m1[3]);
        *(u32x4*)(AG + (size_t)(MP + b) * KAG + DATT + 8 * lane) = w;
    }
    __syncthreads();
}


#define INP(k) (args.in[k])
#define WSB(off) ((bf16_t*)(ws + (off)))
#define WSF(off) ((float*)(ws + (off)))
#define x_prompt INP(0)
#define x_sample INP(1)
#define c_prompt INP(2)
#define c_sample INP(3)
#define cache0 INP(4)
#define cache1 INP(5)
#define cache2 INP(6)
#define ada_w INP(7)
#define ada_b INP(8)
#define norm_g INP(9)
#define ffn1_up INP(10)
#define ffn1_down INP(11)
#define w_in INP(12)
#define w_ba INP(13)
#define w_bb INP(14)
#define w_out INP(15)
#define v_ln_g INP(16)
#define v_ln_b INP(17)
#define w_sp INP(18)
#define b_sp INP(19)
#define ffn2_up INP(20)
#define ffn2_down INP(21)
#define final_g INP(22)
#define W1U WSB(WS_W1U)
#define W1D WSB(WS_W1D)
#define WIN WSB(WS_WIN)
#define WAB WSB(WS_WAB)
#define WO WSB(WS_WO)
#define W2U WSB(WS_W2U)
#define W2D WSB(WS_W2D)
#define ADAW WSB(WS_ADAW)
#define AADA WSB(WS_AADA)
#define MOD WSF(WS_MOD)
#define WSP WSB(WS_WSP)
#define XS WSF(WS_XS)
#define PROJS WSF(WS_PROJS)
#define LSE WSF(WS_LSE)
#define XN WSB(WS_XN)
#define HB WSB(WS_H)
#define QKV WSB(WS_QKV)
#define UB WSB(WS_U)
#define VBB WSB(WS_VB)
#define SA WSB(WS_SA)
#define SB WSB(WS_SB)
#define AG WSB(WS_AG)
#define MG WSB(WS_MG)
#define YP (out + O_YP)
#define LANE_VARS() int tidv = threadIdx.x; asm volatile("" : "+v"(tidv)); const int lane = tidv & 63, fr = lane & 15, fq = lane >> 4; const size_t gt = (size_t)vcu * (NWAVES * 64) + tidv; (void)lane; (void)fr; (void)fq; (void)gt
__global__ void __launch_bounds__(NWAVES * 64, 2) fwd_kernel(Args args) {
    extern __shared__ __attribute__((aligned(16))) unsigned char lds_raw[];
    LAS unsigned char* lds = (LAS unsigned char*)lds_raw;
    const int tid = threadIdx.x, wave = __builtin_amdgcn_readfirstlane(tid >> 6);
    const int G = gridDim.x, bx = blockIdx.x;
    const int vcu = (G % 8 == 0) ? (bx % 8) * (G / 8) + bx / 8 : bx;
    const int gw = vcu * NWAVES + wave, NGW = G * NWAVES;
    const size_t NT = (size_t)G * (NWAVES * 64);
    unsigned char* ws = args.ws;
    unsigned* ctl = (unsigned*)(ws + WS_CTL);
    for (int u = tid; u < (LDS_BYTES - LDSCTL_OFF) / 4; u += NWAVES * 64) ((LAS unsigned*)(lds + LDSCTL_OFF))[u] = 0u;
    __syncthreads();
    volatile LAS unsigned* MISC = (volatile LAS unsigned*)(lds + MISC_OFF);
    XcdBarrier bar; bar.bar = ctl + CW_BAR; bar.x = 0; bar.st = nullptr;
    bar = xcd_barrier_post(ctl + CW_BAR + args.li * XCD_BAR_WORDS, MISC + 8);
#define GRID_BAR() xcd_barrier(bar)
    const int lo = args.ph_lo, hi = args.ph_hi;
#define IN(k) (lo <= (k) && (k) < hi)
#define BOTH(k) (IN(k) && IN((k) + 1))
    float* const out = args.out;
#if SIMPLE_GEMM
#define RUN_GEMM(EPI, g, S, E) pg8::gemm_simple<EPI, pg8::StaticOrder>(g, S, E)
#else
#define RUN_GEMM(EPI, g, S, E) pg8::gemm_phase<EPI, pg8::StaticOrder, true, true>(lds + RING_OFF, g, S, E)
#endif

    if (IN(0)) {
        LANE_VARS();
        LAS float* scr = (LAS float*)(lds + RING_OFF + wave * 16384);
        constexpr int I_ADA = (D / 64) * (NADA / 32), I_UP = (D / 64) * (2 * FF / 32), I_DN = (FF / 64) * (D / 32), I_IN = (D / 64) * (DIN / 32), I_A = (DATT / 64) * (D / 32), I_B = (DG / 64) * (D / 32), I_O = (D / 64) * (D / 32);
        constexpr int NITEMS = I_ADA + 2 * I_UP + 2 * I_DN + I_IN + I_A + I_B + I_O;
        for (int it = gw; it < NITEMS; it += NGW) {
            int r = it;
            if (r < I_ADA) { p0_transpose_item(ada_w, D, NADA, ADAW, D, 0, 0, scr, r, lane); continue; } r -= I_ADA;
            if (r < I_UP) { p0_transpose_item(ffn1_up, D, 2 * FF, W1U, D, 0, 1, scr, r, lane); continue; } r -= I_UP;
            if (r < I_DN) { p0_transpose_item(ffn1_down, FF, D, W1D, FF, 0, 0, scr, r, lane); continue; } r -= I_DN;
            if (r < I_IN) { p0_transpose_item(w_in, D, DIN, WIN, D, 0, 0, scr, r, lane); continue; } r -= I_IN;
            if (r < I_A) { p0_transpose_item(w_ba, DATT, D, WAB, KAG, 0, 0, scr, r, lane); continue; } r -= I_A;
            if (r < I_B) { p0_transpose_item(w_bb, DG, D, WAB, KAG, DATT, 0, scr, r, lane); continue; } r -= I_B;
            if (r < I_O) { p0_transpose_item(w_out, D, D, WO, D, 0, 0, scr, r, lane); continue; } r -= I_O;
            if (r < I_UP) { p0_transpose_item(ffn2_up, D, 2 * FF, W2U, D, 0, 1, scr, r, lane); continue; } r -= I_UP;
            p0_transpose_item(ffn2_down, FF, D, W2D, FF, 0, 0, scr, r, lane);
        }
        for (size_t i = gt; i < (size_t)NMOD * D / 4; i += NT) {
            const f32x4 c = (i < (size_t)NB * D / 4) ? ((const f32x4*)c_prompt)[i] : ((const f32x4*)c_sample)[i - (size_t)NB * D / 4];
            u32x2 w; w.x = cvt_pk_bf16(siluf_(c[0]), siluf_(c[1])); w.y = cvt_pk_bf16(siluf_(c[2]), siluf_(c[3]));
            ((u32x2*)AADA)[i] = w;
        }
        for (size_t i = gt; i < (size_t)4 * 128 * 128 / 4; i += NT) {
            const int j0 = (int)(i & 31) * 4, rr = (int)(i >> 5) & 127;
            const f32x4 v = ((const f32x4*)w_sp)[i];
            u32x2 w; w.x = cvt_pk_bf16(j0 <= rr ? v[0] : 0.f, j0 + 1 <= rr ? v[1] : 0.f); w.y = cvt_pk_bf16(j0 + 2 <= rr ? v[2] : 0.f, j0 + 3 <= rr ? v[3] : 0.f);
            ((u32x2*)WSP)[i] = w;
        }
        kv_copy(cache0, out + O_KV0S, 128, gt, NT);
        kv_copy(cache1, out + O_KV1S, 512, gt, NT);
        kv_copy(cache2, out + O_KV2S, 2048, gt, NT);
        if (BOTH(0)) GRID_BAR();
    }

    if (IN(1)) {
        LANE_VARS();
        for (int it = vcu; it < NADA / 16; it += G)
            for (int rb = wave; rb < NMOD / 16; rb += NWAVES) {
                f32x4 acc[1]; acc[0] = (f32x4){0.f, 0.f, 0.f, 0.f};
                const bf16_t* bp = ADAW + (size_t)(16 * it + fr) * D + 8 * fq;
                skinny_dot<1>(acc, AADA + (size_t)(16 * rb + fr) * D + 8 * fq, bp, bp, D / 32);
                const int col = 16 * it + 4 * fq;
                *(f32x4*)(MOD + (size_t)(16 * rb + fr) * NADA + col) = acc[0] + *(const f32x4*)(ada_b + col);
            }
        if (BOTH(1)) GRID_BAR();
    }

    if (IN(2)) { LANE_VARS(); norm_mod_rows(x_prompt, x_sample, norm_g, MOD, 0, XN, gw, NGW, lane); if (BOTH(2)) GRID_BAR(); }

#define FFN_UP_PHASE(WU) do { \
        for (int it = vcu; it < FF / 16; it += G) {                                      \
            const int j0 = 16 * it, ra = 256 * (j0 >> 7) + (j0 & 127) + fr; \
            f32x4 acc[2]; acc[0] = (f32x4){0.f, 0.f, 0.f, 0.f}; acc[1] = acc[0]; \
            const size_t row = (size_t)MP + 16 * wave + fr; \
            skinny_dot<2>(acc, XN + row * D + 8 * fq, (WU) + (size_t)ra * D + 8 * fq, (WU) + (size_t)(ra + 128) * D + 8 * fq, D / 32); \
            u32x2 w; w.x = cvt_pk_bf16(siluf_(acc[0][0]) * acc[1][0], siluf_(acc[0][1]) * acc[1][1]); w.y = cvt_pk_bf16(siluf_(acc[0][2]) * acc[1][2], siluf_(acc[0][3]) * acc[1][3]); \
            *(u32x2*)(HB + row * FF + j0 + 4 * fq) = w; } \
        pg8::Gemm g{XN, (WU), MP, 2 * FF, D}; pg8::StaticOrder S; S.init(MP, 2 * FF, G, bx); pg8::EpiUp E{HB}; \
        RUN_GEMM(pg8::EpiUp, g, S, E); } while (0)
#define FFN_DOWN_PHASE(WD, BASEP, BASES, GIDX) do { \
        for (int it = vcu; it < D / 16; it += G) { \
            f32x4 acc[1]; acc[0] = (f32x4){0.f, 0.f, 0.f, 0.f}; \
            const int srow = 16 * wave + fr, col = 16 * it + 4 * fq; \
            const bf16_t* bp = (WD) + (size_t)(16 * it + fr) * FF + 8 * fq; \
            skinny_dot<1>(acc, HB + (size_t)(MP + srow) * FF + 8 * fq, bp, bp, FF / 32); \
            const f32x4 gv = *(const f32x4*)(MOD + (size_t)(NB + srow) * NADA + (GIDX) * D + col) * 0.5f; \
            *(f32x4*)(XS + (size_t)srow * D + col) = *(const f32x4*)((BASES) + (size_t)srow * D + col) + gv * acc[0]; } \
        pg8::Gemm g{HB, (WD), MP, D, FF}; pg8::StaticOrder S; S.init(MP, D, G, bx); pg8::EpiResid E{(BASEP), YP, MOD, (GIDX), 0.5f}; \
        RUN_GEMM(pg8::EpiResid, g, S, E); } while (0)

    if (IN(3)) { LANE_VARS(); FFN_UP_PHASE(W1U); if (BOTH(3)) GRID_BAR(); }
    if (IN(4)) { LANE_VARS(); FFN_DOWN_PHASE(W1D, x_prompt, x_sample, 2); if (BOTH(4)) GRID_BAR(); }

    if (IN(5)) { LANE_VARS(); norm_mod_rows(YP, XS, norm_g + D, MOD, 1, XN, gw, NGW, lane); if (BOTH(5)) GRID_BAR(); }

    if (IN(6)) {
        LANE_VARS();
        for (int it = vcu; it < DIN / 16; it += G) {
            f32x4 acc[1]; acc[0] = (f32x4){0.f, 0.f, 0.f, 0.f};
            const int srow = 16 * wave + fr, col = 16 * it + 4 * fq;
            const bf16_t* bp = WIN + (size_t)(16 * it + fr) * D + 8 * fq;
            skinny_dot<1>(acc, XN + (size_t)(MP + srow) * D + 8 * fq, bp, bp, D / 32);
            *(f32x4*)(PROJS + (size_t)srow * DIN + col) = acc[0];
            if (col >= DATT && col < 3 * DATT) {
                const int isv = col >= 2 * DATT ? 1 : 0, cc = col - (isv ? 2 * DATT : DATT), g = cc >> 8, L = 128 << (2 * g);
                const size_t ob = (g == 0 ? O_KV0S : (g == 1 ? O_KV1S : O_KV2S)) + ((size_t)srow * L + (L - 1)) * 512 + isv * 256 + (cc & 255);
                *(f32x4*)(out + ob) = acc[0];
            }
        }
        pg8::Gemm g{XN, WIN, MP, DIN, D}; pg8::StaticOrder S; S.init(MP, DIN, G, bx); pg8::EpiProj E{QKV, UB, VBB, SA, SB, out};
        RUN_GEMM(pg8::EpiProj, g, S, E);
        if (BOTH(6)) GRID_BAR();
    }

    if (IN(7)) {
        LANE_VARS();
        attn_prompt_phase(lds + RING_OFF, QKV, AG, LSE, vcu, G, tidv, wave, lane);
        gmlp_phase(lds + RING_OFF, VBB, UB, WSP, b_sp, v_ln_g, v_ln_b, AG, out, vcu, G, wave, lane);
        for (int u = vcu; u < DB; u += G) sample_unit(lds, PROJS, cache0, cache1, cache2, w_sp, b_sp, v_ln_g, v_ln_b, AG, out, u, tidv, wave, lane);
        if (BOTH(7)) GRID_BAR();
    }

    if (IN(8)) {
        LANE_VARS();
        for (size_t i = gt; i < (size_t)MP * 96; i += NT) {
            const size_t t = i / 96; const int ch = (int)(i - t * 96), head = ch >> 3, hh = head & 3, g = head >> 2;
            const float l0 = LSE[t * 12 + hh], l1 = LSE[t * 12 + 4 + hh], l2 = LSE[t * 12 + 8 + hh], m = fmaxf(l0, fmaxf(l1, l2));
            const float e0 = __expf(l0 - m), e1 = __expf(l1 - m), e2 = __expf(l2 - m);
            const float w = (g == 0 ? e0 : (g == 1 ? e1 : e2)) / (e0 + e1 + e2);
            u32x4* p = (u32x4*)(AG + t * KAG + ch * 8); const u32x4 v = *p;
            u32x4 o; o.x = cvt_pk_bf16(bflo(v.x) * w, bfhi(v.x) * w); o.y = cvt_pk_bf16(bflo(v.y) * w, bfhi(v.y) * w); o.z = cvt_pk_bf16(bflo(v.z) * w, bfhi(v.z) * w); o.w = cvt_pk_bf16(bflo(v.w) * w, bfhi(v.w) * w);
            *p = o;
        }
        if (BOTH(8)) GRID_BAR();
    }

    if (IN(9)) {
        LANE_VARS();
        for (int it = vcu; it < D / 16; it += G) {
            f32x4 a0[1], a1[1]; a0[0] = (f32x4){0.f, 0.f, 0.f, 0.f}; a1[0] = a0[0];
            const int srow = 16 * wave + fr, col = 16 * it + 4 * fq;
            const bf16_t* bp = WAB + (size_t)(16 * it + fr) * KAG + 8 * fq; const bf16_t* ap = AG + (size_t)(MP + srow) * KAG + 8 * fq;
            skinny_dot<1>(a0, ap, bp, bp, DATT / 32);
            skinny_dot<1>(a1, ap + DATT, bp + DATT, bp + DATT, DG / 32);
            const f32x4 ga = *(const f32x4*)(PROJS + (size_t)srow * DIN + 3328 + col), gb = *(const f32x4*)(PROJS + (size_t)srow * DIN + 4352 + col);
            u32x2 w; w.x = cvt_pk_bf16(sigmoidf_(ga[0]) * a0[0][0] + sigmoidf_(gb[0]) * a1[0][0], sigmoidf_(ga[1]) * a0[0][1] + sigmoidf_(gb[1]) * a1[0][1]);
            w.y = cvt_pk_bf16(sigmoidf_(ga[2]) * a0[0][2] + sigmoidf_(gb[2]) * a1[0][2], sigmoidf_(ga[3]) * a0[0][3] + sigmoidf_(gb[3]) * a1[0][3]);
            *(u32x2*)(MG + (size_t)(MP + srow) * D + col) = w;
        }
        pg8::Gemm g{AG, WAB, MP, D, KAG}; pg8::StaticOrder S; S.init(MP, D, G, bx); pg8::EpiMerge E{SA, SB, MG};
        RUN_GEMM(pg8::EpiMerge, g, S, E);
        if (BOTH(9)) GRID_BAR();
    }

    if (IN(10)) {
        LANE_VARS();
        for (int it = vcu; it < D / 16; it += G) {
            f32x4 acc[1]; acc[0] = (f32x4){0.f, 0.f, 0.f, 0.f};
            const int srow = 16 * wave + fr, col = 16 * it + 4 * fq;
            const bf16_t* bp = WO + (size_t)(16 * it + fr) * D + 8 * fq;
            skinny_dot<1>(acc, MG + (size_t)(MP + srow) * D + 8 * fq, bp, bp, D / 32);
            const f32x4 gv = *(const f32x4*)(MOD + (size_t)(NB + srow) * NADA + 5 * D + col);
            *(f32x4*)(XS + (size_t)srow * D + col) = *(const f32x4*)(XS + (size_t)srow * D + col) + gv * acc[0];
        }
        pg8::Gemm g{MG, WO, MP, D, D}; pg8::StaticOrder S; S.init(MP, D, G, bx); pg8::EpiResid E{YP, YP, MOD, 5, 1.0f};
        RUN_GEMM(pg8::EpiResid, g, S, E);
        if (BOTH(10)) GRID_BAR();
    }

    if (IN(11)) { LANE_VARS(); norm_mod_rows(YP, XS, norm_g + 2 * D, MOD, 2, XN, gw, NGW, lane); if (BOTH(11)) GRID_BAR(); }

    if (IN(12)) { LANE_VARS(); FFN_UP_PHASE(W2U); if (BOTH(12)) GRID_BAR(); }
    if (IN(13)) { LANE_VARS(); FFN_DOWN_PHASE(W2D, YP, XS, 8); if (BOTH(13)) GRID_BAR(); }

    if (IN(14)) { LANE_VARS(); final_norm_rows(YP, XS, out + O_YS, final_g, gw, NGW, lane); }
#undef IN
#undef BOTH
}

extern "C" void kernel_launch(void* const* d_in, const int* in_sizes, int n_in, void* d_out, int out_size, void* d_ws, size_t ws_size, hipStream_t stream) {
    static int grid = 0;
    if (grid == 0) {
        if (n_in != 23 || in_sizes[0] != MP * D || (size_t)out_size != O_END || ws_size < WS_END) {
            fprintf(stderr, "kernel_launch: unexpected shapes: n_in %d, in0 %d, out %d, ws %zu (need %zu); nothing launched\n", n_in, n_in > 0 ? in_sizes[0] : -1, out_size, ws_size, (size_t)WS_END); grid = -1; return; }
        int dev = 0, cus = 0, per_cu = 0;
        if (hipGetDevice(&dev) != hipSuccess || hipDeviceGetAttribute(&cus, hipDeviceAttributeMultiprocessorCount, dev) != hipSuccess) { fprintf(stderr, "kernel_launch: device query failed\n"); grid = -1; return; }
        if (hipFuncSetAttribute((const void*)fwd_kernel, hipFuncAttributeMaxDynamicSharedMemorySize, LDS_BYTES) != hipSuccess) { fprintf(stderr, "kernel_launch: hipFuncSetAttribute failed\n"); grid = -1; return; }
        if (hipOccupancyMaxActiveBlocksPerMultiprocessor(&per_cu, (const void*)fwd_kernel, NWAVES * 64, LDS_BYTES) != hipSuccess || per_cu < 1)
            fprintf(stderr, "kernel_launch: note: occupancy query reports %d workgroups per CU\n", per_cu);
        (void)hipGetLastError();
        grid = cus;
    }
    if (grid < 0) return;
    if (hipMemsetAsync((char*)d_ws + WS_CTL, 0, CTL_ZERO_BYTES, stream) != hipSuccess) { fprintf(stderr, "kernel_launch: hipMemsetAsync failed\n"); return; }
    Args a{};
    for (int i = 0; i < 23; ++i) a.in[i] = (const float*)d_in[i];
    a.out = (float*)d_out; a.ws = (unsigned char*)d_ws;
    for (int li = 0; li < N_LAUNCHES; ++li) {
        a.ph_lo = SEGS[2 * li]; a.ph_hi = SEGS[2 * li + 1]; a.li = li; a.pad = 0;
        hipLaunchKernelGGL(fwd_kernel, dim3(grid), dim3(NWAVES * 64), LDS_BYTES, stream, a);
        const hipError_t le = hipPeekAtLastError();
        if (le != hipSuccess) { fprintf(stderr, "kernel_launch: launch %d failed: %s\n", li, hipGetErrorName(le)); break; }
    }
}
```

```cpp
#include <hip/hip_runtime.h>
#include <cstdio>
#include <cstdint>

#define LAS __attribute__((address_space(3)))
#define GAS __attribute__((address_space(1)))
typedef unsigned short bf16_t;
typedef short bf16x8 __attribute__((ext_vector_type(8)));
typedef short s16x4 __attribute__((ext_vector_type(4)));
typedef float f32x4 __attribute__((ext_vector_type(4)));
typedef float f32x2 __attribute__((ext_vector_type(2)));
typedef float f32x16 __attribute__((ext_vector_type(16)));
typedef unsigned u32x4 __attribute__((ext_vector_type(4)));
typedef unsigned u32x2 __attribute__((ext_vector_type(2)));
typedef GAS unsigned gu32;

#ifndef SIMPLE_GEMM
#define SIMPLE_GEMM 0
#endif

constexpr int D = 1024, NB = 16, SEQ = 4096, MP = NB * SEQ  , DB = 128  , MPAD = MP + 256;
constexpr int FF = 2816, DIN = 5376, DATT = 768, DG = 512, KAG = DATT + DG  , NADA = 9 * D;
constexpr int NMOD = NB + DB;
constexpr float EPS = 1e-6f;
constexpr size_t O_YP = 0, O_YS = 67108864, O_KV0P = 67239936, O_KV1P = 68288512, O_KV2P = 72482816, O_VRP = 89260032,
                 O_KV0S = 90308608, O_KV1S = 98697216, O_KV2S = 132251648, O_VRS = 266469376, O_END = 266534912;

constexpr size_t MiB = 1u << 20;
constexpr size_t WS_CTL = 0, CTL_ZERO_BYTES = 2 * MiB;
constexpr size_t WS_RSS1 = 1 * MiB, WS_RSS2 = 1 * MiB + 512 * 1024;
constexpr size_t WS_W1U = 2 * MiB, WS_W1D = 13 * MiB, WS_WIN = 19 * MiB, WS_WAB = 30 * MiB, WS_WO = 33 * MiB, WS_W2U = 35 * MiB, WS_W2D = 46 * MiB, WS_ADAW = 52 * MiB;
constexpr size_t WS_AADA = 70 * MiB;
constexpr size_t WS_NG = 70 * MiB + 512 * 1024;
constexpr size_t WS_MOD = 71 * MiB;
constexpr size_t WS_WSP = 77 * MiB;
constexpr size_t WS_XS = 78 * MiB;
constexpr size_t WS_PROJS = 79 * MiB;
constexpr size_t WS_LSE = 82 * MiB;
constexpr size_t WS_SH1 = 85 * MiB, WS_SH2 = 85 * MiB + 512 * 1024;
constexpr size_t WS_BIAS1 = 86 * MiB, WS_BIAS2 = 90 * MiB;
constexpr size_t WS_XN = 96 * MiB;
constexpr size_t WS_H = 226 * MiB;
constexpr size_t WS_QKV = 226 * MiB;
constexpr size_t WS_U = 514 * MiB;
constexpr size_t WS_VB = 580 * MiB;
constexpr size_t WS_SA = 644 * MiB, WS_SB = 772 * MiB;
constexpr size_t WS_AG = 900 * MiB;
constexpr size_t WS_MG = 1062 * MiB;
constexpr size_t WS_END = 1192 * MiB;
static_assert(WS_W1U + (size_t)2 * FF * D * 2 <= WS_W1D && WS_W1D + (size_t)D * FF * 2 <= WS_WIN && WS_WIN + (size_t)DIN * D * 2 <= WS_WAB && WS_WAB + (size_t)D * KAG * 2 <= WS_WO && WS_WO + (size_t)D * D * 2 <= WS_W2U, "ws map 1");
static_assert(WS_W2U + (size_t)2 * FF * D * 2 <= WS_W2D && WS_W2D + (size_t)D * FF * 2 <= WS_ADAW && WS_ADAW + (size_t)NADA * D * 2 <= WS_AADA && WS_MOD + (size_t)NMOD * NADA * 4 <= WS_WSP, "ws map 2");
static_assert((size_t)MPAD * 4 <= 512 * 1024 && WS_BIAS1 + (size_t)NMOD * DIN * 4 <= WS_BIAS2 && WS_BIAS2 + (size_t)NMOD * 2 * FF * 4 <= WS_XN, "ws map 6");
static_assert(WS_PROJS + (size_t)DB * DIN * 4 <= WS_LSE && WS_LSE + (size_t)MP * 12 * 4 <= WS_SH1 && WS_XN + (size_t)MPAD * D * 2 <= WS_H && WS_H + (size_t)MPAD * FF * 2 <= WS_VB, "ws map 3");
static_assert(WS_QKV + (size_t)MP * 2304 * 2 <= WS_U && WS_U + (size_t)MP * DG * 2 <= WS_VB && WS_VB + (size_t)MP * DG * 2 <= WS_SA && WS_SA + (size_t)MP * D * 2 <= WS_SB && WS_SB + (size_t)MP * D * 2 <= WS_AG, "ws map 4");
static_assert(WS_AG + (size_t)MPAD * KAG * 2 <= WS_MG && WS_MG + (size_t)MPAD * D * 2 <= WS_END, "ws map 5");

__device__ __forceinline__ unsigned cvt_pk_bf16(float lo, float hi) { unsigned r; asm volatile("v_cvt_pk_bf16_f32 %0, %1, %2" : "=v"(r) : "v"(lo), "v"(hi)); return r; }
__device__ __forceinline__ float bf2f(unsigned short b) { return __uint_as_float((unsigned)b << 16); }
__device__ __forceinline__ float bflo(unsigned w) { return __uint_as_float(w << 16); }
__device__ __forceinline__ float bfhi(unsigned w) { return __uint_as_float(w & 0xffff0000u); }
__device__ __forceinline__ float fast_rcp(float x) { return __builtin_amdgcn_rcpf(x); }
__device__ __forceinline__ float sigmoidf_(float x) { return fast_rcp(1.0f + __builtin_amdgcn_exp2f(-1.44269504089f * x)); }
__device__ __forceinline__ float siluf_(float x) { return x * sigmoidf_(x); }

namespace pg8 {
#define PG8_LAS __attribute__((address_space(3)))
constexpr int BM = 256, BK = 64, HALF = 128, HTB = HALF * BK * 2  , STAGE_BYTES = 8 * HTB, NXCD = 8, WGM = 8;

__host__ __device__ __forceinline__ int lds_byte(int r, int c) { const int st = (r >> 4) * 2 + (c >> 5), rr = r & 15, cc = c & 31, ob = rr * 64 + cc * 2; return st * 1024 + (ob ^ (((ob >> 9) & 1) << 5)); }
__host__ __device__ __forceinline__ void stage_rc(int b, int& R, int& C) { const int st = b / 1024, sb = b % 1024, swz = sb ^ (((sb >> 9) & 1) << 5); R = (st >> 1) * 16 + swz / 64; C = (st & 1) * 32 + (swz % 64) / 2; }
__host__ __device__ __forceinline__ int perm32(int rho) { const int n = rho >> 4, i = rho & 15; return 8 * (i >> 2) + 4 * n + (i & 3); }

struct Unit { int pm, pn; };
struct Gemm { const bf16_t* A; const bf16_t* Bt; int M, N, K; };

struct StaticOrder {
    int nM, nN, nwg, G, c;
    __host__ __device__ void init(int M, int N, int G_, int c_) { nM = M / BM; nN = N / BM; nwg = nM * nN; G = G_; c = c_; }
    __host__ __device__ bool next(int i, Unit& u) const {
        const long L = (long)i * G + c; if (L >= nwg) return false;
        int wgid = (int)L; { const int q = nwg / NXCD, r = nwg % NXCD, xcd = wgid % NXCD, off = wgid / NXCD; wgid = (xcd < r ? xcd * (q + 1) : r * (q + 1) + (xcd - r) * q) + off; }
        const int nig = WGM * nN, gid = wgid / nig, fm = gid * WGM, gsz = (nM - fm) < WGM ? (nM - fm) : WGM;
        u.pm = fm + ((wgid % nig) % gsz); u.pn = (wgid % nig) / gsz; return true;
    }
    __device__ __forceinline__ void a_ready(const Unit&) const {}
    __device__ __forceinline__ void done(const Unit&) const {}
};


template <bool DEF> struct EpiUp {
    static constexpr bool PERM = true, AFTER_DRAIN = false; static constexpr int MID_T = 0;
    unsigned char* ws;
    __device__ __forceinline__ void operator()(const f32x4 (&acc)[2][2][4][2], const Unit& u, int wr, int wc, int fr, int fq) const {
        const int row0 = u.pm * BM + wr * 64 + fr, col0 = u.pn * HALF + wc * 32 + 8 * fq;
        bf16_t* const H = (bf16_t*)(ws + WS_H); const float* const rss = (const float*)(ws + WS_RSS2); const float* const bias = (const float*)(ws + WS_BIAS2);
        f32x4 bv[2][2];
        if (DEF) { const float* bp = bias + (size_t)(u.pm >> 4) * (2 * FF) + u.pn * BM + wc * 32 + 8 * fq;
#pragma unroll
            for (int bj = 0; bj < 2; ++bj)
#pragma unroll
                for (int n = 0; n < 2; ++n) bv[bj][n] = *(const f32x4*)(bp + bj * HALF + 4 * n); }
        float rr[2][4];
        if (DEF) {
#pragma unroll
            for (int ai = 0; ai < 2; ++ai)
#pragma unroll
                for (int m = 0; m < 4; ++m) rr[ai][m] = rss[row0 + ai * HALF + m * 16]; }
#pragma unroll
        for (int ai = 0; ai < 2; ++ai)
#pragma unroll
            for (int m = 0; m < 4; ++m) {
                f32x4 a0 = acc[ai][0][m][0], a1 = acc[ai][0][m][1], b0 = acc[ai][1][m][0], b1 = acc[ai][1][m][1];
                if (DEF) { const float r = __builtin_amdgcn_rsqf(rr[ai][m] * (1.0f / D) + EPS);
                    a0 = a0 * r + bv[0][0]; a1 = a1 * r + bv[0][1]; b0 = b0 * r + bv[1][0]; b1 = b1 * r + bv[1][1]; }
                u32x4 w;
                w.x = cvt_pk_bf16(siluf_(a0[0]) * b0[0], siluf_(a0[1]) * b0[1]); w.y = cvt_pk_bf16(siluf_(a0[2]) * b0[2], siluf_(a0[3]) * b0[3]);
                w.z = cvt_pk_bf16(siluf_(a1[0]) * b1[0], siluf_(a1[1]) * b1[1]); w.w = cvt_pk_bf16(siluf_(a1[2]) * b1[2], siluf_(a1[3]) * b1[3]);
                *(u32x4*)(H + (size_t)(row0 + ai * HALF + m * 16) * FF + col0) = w;
            }
    }
};
template <bool NORMOUT, int GATE_IDX, int GS2, int NIDX> struct EpiResid {
    static constexpr bool PERM = true, AFTER_DRAIN = false; static constexpr int MID_T = 0;
    const float* base; float* out; unsigned char* ws;
    __device__ __forceinline__ void operator()(const f32x4 (&acc)[2][2][4][2], const Unit& u, int wr, int wc, int fr, int fq) const {
        const float* const mod = (const float*)(ws + WS_MOD); bf16_t* const xn = (bf16_t*)(ws + WS_XN); const float* const gain = (const float*)(ws + WS_NG) + NIDX * D;
        float* const rss = (float*)(ws + (NIDX == 1 ? WS_RSS1 : WS_RSS2)); constexpr int gate_idx = GATE_IDX, sc_idx = 3 * NIDX + 1; constexpr float gs = 0.5f * GS2;
        const int row0 = u.pm * BM + wr * 64 + fr, col0 = u.pn * BM + wc * 32 + 8 * fq;
        const float* mp = mod + (size_t)(u.pm >> 4) * NADA + col0;
        f32x4 gv[2][2], cav[2][2];
#pragma unroll
        for (int bj = 0; bj < 2; ++bj)
#pragma unroll
            for (int n = 0; n < 2; ++n) { gv[bj][n] = *(const f32x4*)(mp + gate_idx * D + bj * HALF + 4 * n) * gs;
                if (NORMOUT) cav[bj][n] = *(const f32x4*)(gain + col0 + bj * HALF + 4 * n) * (*(const f32x4*)(mp + sc_idx * D + bj * HALF + 4 * n) + 1.0f); }
#pragma unroll
        for (int hq = 0; hq < 4; ++hq) {
            const int ai = hq >> 1, m0 = (hq & 1) * 2;
            f32x4 bs[2][2][2];
#pragma unroll
            for (int mm = 0; mm < 2; ++mm)
#pragma unroll
                for (int bj = 0; bj < 2; ++bj) { const size_t off = (size_t)(row0 + ai * HALF + (m0 + mm) * 16) * D + col0 + bj * HALF; bs[mm][bj][0] = *(const f32x4*)(base + off); bs[mm][bj][1] = *(const f32x4*)(base + off + 4); }
#pragma unroll
            for (int mm = 0; mm < 2; ++mm) { const int m = m0 + mm, row = row0 + ai * HALF + m * 16; const size_t off = (size_t)row * D + col0; float ss = 0.f;
#pragma unroll
                for (int bj = 0; bj < 2; ++bj) {
                    const f32x4 o0 = bs[mm][bj][0] + gv[bj][0] * acc[ai][bj][m][0], o1 = bs[mm][bj][1] + gv[bj][1] * acc[ai][bj][m][1];
                    *(f32x4*)(out + off + bj * HALF) = o0; *(f32x4*)(out + off + bj * HALF + 4) = o1;
                    if (NORMOUT) { ss += (o0[0] * o0[0] + o0[1] * o0[1]) + (o0[2] * o0[2] + o0[3] * o0[3]) + (o1[0] * o1[0] + o1[1] * o1[1]) + (o1[2] * o1[2] + o1[3] * o1[3]);
                        const f32x4 x0 = o0 * cav[bj][0], x1 = o1 * cav[bj][1];
                        u32x4 w; w.x = cvt_pk_bf16(x0[0], x0[1]); w.y = cvt_pk_bf16(x0[2], x0[3]); w.z = cvt_pk_bf16(x1[0], x1[1]); w.w = cvt_pk_bf16(x1[2], x1[3]);
                        *(u32x4*)(xn + off + bj * HALF) = w; } }
                if (NORMOUT) { ss += __shfl_xor(ss, 16); ss += __shfl_xor(ss, 32); if (fq == 0) atomicAdd(rss + row, ss); } }
        }
    }
};
struct EpiProj {
    static constexpr bool PERM = true, AFTER_DRAIN = false; static constexpr int MID_T = 0;
    unsigned char* ws; float* out;
    __device__ __forceinline__ void operator()(f32x4 (&acc)[2][2][4][2], const Unit& u, int wr, int wc, int fr, int fq) const {
        const int pn = u.pn, row0 = u.pm * BM + wr * 64 + fr, c8 = wc * 32 + 8 * fq;
        bf16_t* const QKV = (bf16_t*)(ws + WS_QKV); bf16_t* const U = (bf16_t*)(ws + WS_U); bf16_t* const VB = (bf16_t*)(ws + WS_VB); bf16_t* const SA = (bf16_t*)(ws + WS_SA); bf16_t* const SB = (bf16_t*)(ws + WS_SB);
        const float* const rss = (const float*)(ws + WS_RSS1); const float* const bias = (const float*)(ws + WS_BIAS1);
        { const float* bp = bias + (size_t)(u.pm >> 4) * DIN + pn * BM + c8; f32x4 bv[2][2];
#pragma unroll
          for (int bj = 0; bj < 2; ++bj)
#pragma unroll
              for (int n = 0; n < 2; ++n) bv[bj][n] = *(const f32x4*)(bp + bj * HALF + 4 * n);
#pragma unroll
          for (int ai = 0; ai < 2; ++ai)
#pragma unroll
              for (int m = 0; m < 4; ++m) { const float r = __builtin_amdgcn_rsqf(rss[row0 + ai * HALF + m * 16] * (1.0f / D) + EPS);
#pragma unroll
                  for (int bj = 0; bj < 2; ++bj)
#pragma unroll
                      for (int n = 0; n < 2; ++n) acc[ai][bj][m][n] = acc[ai][bj][m][n] * r + bv[bj][n]; } }
        bf16_t* dst; int ld; bool sig = false;
        if (pn < 9) { dst = QKV + pn * BM; ld = 3 * DATT; }
        else if (pn < 11) { dst = U + (pn - 9) * BM; ld = DG; }
        else if (pn < 13) { dst = VB + (pn - 11) * BM; ld = DG; }
        else if (pn < 17) { dst = SA + (pn - 13) * BM; ld = D; sig = true; }
        else { dst = SB + (pn - 17) * BM; ld = D; sig = true; }
#pragma unroll
        for (int ai = 0; ai < 2; ++ai)
#pragma unroll
            for (int m = 0; m < 4; ++m) { bf16_t* rowp = dst + (size_t)(row0 + ai * HALF + m * 16) * ld + c8;
#pragma unroll
                for (int bj = 0; bj < 2; ++bj) { f32x4 v0 = acc[ai][bj][m][0], v1 = acc[ai][bj][m][1];
                    if (sig) {
#pragma unroll
                        for (int e = 0; e < 4; ++e) { v0[e] = sigmoidf_(v0[e]); v1[e] = sigmoidf_(v1[e]); } }
                    u32x4 w; w.x = cvt_pk_bf16(v0[0], v0[1]); w.y = cvt_pk_bf16(v0[2], v0[3]); w.z = cvt_pk_bf16(v1[0], v1[1]); w.w = cvt_pk_bf16(v1[2], v1[3]);
                    *(u32x4*)(rowp + bj * HALF) = w; } }
        if (pn >= 3 && pn < 9) {
            const int g = (pn - 3) % 3, isv = (pn >= 6) ? 1 : 0, win = 128 << (2 * g), b = u.pm >> 4, t0 = (u.pm & 15) * BM;
            if (t0 + BM > SEQ - win) {
                const size_t obase = (g == 0 ? O_KV0P : (g == 1 ? O_KV1P : O_KV2P)) + (size_t)b * win * 512 + isv * 256 + c8;
#pragma unroll
                for (int ai = 0; ai < 2; ++ai)
#pragma unroll
                    for (int m = 0; m < 4; ++m) { const int i = t0 + ai * HALF + wr * 64 + m * 16 + fr - (SEQ - win);
                        if (i >= 0) { float* p = out + obase + (size_t)i * 512;
#pragma unroll
                            for (int bj = 0; bj < 2; ++bj) { *(f32x4*)(p + bj * HALF) = acc[ai][bj][m][0]; *(f32x4*)(p + bj * HALF + 4) = acc[ai][bj][m][1]; } } }
            }
        }
    }
};
struct EpiMerge {
    static constexpr bool PERM = true, AFTER_DRAIN = false; static constexpr int MID_T = DATT / 64;
    unsigned char* ws;
    __device__ __forceinline__ void mid(f32x4 (&acc)[2][2][4][2], const Unit& u, int wr, int wc, int fr, int fq) const {
        const bf16_t* const SA = (const bf16_t*)(ws + WS_SA); const bf16_t* const SB = (const bf16_t*)(ws + WS_SB);
        int row0 = u.pm * BM + wr * 64 + fr; const int col0 = u.pn * BM + wc * 32 + 8 * fq;
        asm volatile("" : "+v"(row0));
#pragma unroll
        for (int ai = 0; ai < 2; ++ai) {
            u32x4 av[4][2], bv[4][2];
#pragma unroll
            for (int m = 0; m < 4; ++m)
#pragma unroll
                for (int bj = 0; bj < 2; ++bj) { const size_t off = (size_t)(row0 + ai * HALF + m * 16) * D + col0 + bj * HALF; av[m][bj] = *(const u32x4*)(SA + off); bv[m][bj] = *(const u32x4*)(SB + off); }
#pragma unroll
            for (int m = 0; m < 4; ++m)
#pragma unroll
                for (int bj = 0; bj < 2; ++bj) { const u32x4 a = av[m][bj], b = bv[m][bj];
                    f32x4 r0, r1;
                    r0[0] = bflo(a.x) * fast_rcp(bflo(b.x)); r0[1] = bfhi(a.x) * fast_rcp(bfhi(b.x)); r0[2] = bflo(a.y) * fast_rcp(bflo(b.y)); r0[3] = bfhi(a.y) * fast_rcp(bfhi(b.y));
                    r1[0] = bflo(a.z) * fast_rcp(bflo(b.z)); r1[1] = bfhi(a.z) * fast_rcp(bfhi(b.z)); r1[2] = bflo(a.w) * fast_rcp(bflo(b.w)); r1[3] = bfhi(a.w) * fast_rcp(bfhi(b.w));
                    acc[ai][bj][m][0] *= r0; acc[ai][bj][m][1] *= r1; }
        }
    }
    __device__ __forceinline__ void operator()(const f32x4 (&acc)[2][2][4][2], const Unit& u, int wr, int wc, int fr, int fq) const {
        const bf16_t* const SB = (const bf16_t*)(ws + WS_SB); bf16_t* const MG = (bf16_t*)(ws + WS_MG);
        const int row0 = u.pm * BM + wr * 64 + fr, col0 = u.pn * BM + wc * 32 + 8 * fq;
        u32x4 bv[2][4][2];
#pragma unroll
        for (int ai = 0; ai < 2; ++ai)
#pragma unroll
            for (int m = 0; m < 4; ++m)
#pragma unroll
                for (int bj = 0; bj < 2; ++bj) bv[ai][m][bj] = *(const u32x4*)(SB + (size_t)(row0 + ai * HALF + m * 16) * D + col0 + bj * HALF);
#pragma unroll
        for (int ai = 0; ai < 2; ++ai)
#pragma unroll
            for (int m = 0; m < 4; ++m) { const size_t off = (size_t)(row0 + ai * HALF + m * 16) * D + col0;
#pragma unroll
                for (int bj = 0; bj < 2; ++bj) { const u32x4 b = bv[ai][m][bj]; const f32x4 v0 = acc[ai][bj][m][0], v1 = acc[ai][bj][m][1];
                    u32x4 w; w.x = cvt_pk_bf16(v0[0] * bflo(b.x), v0[1] * bfhi(b.x)); w.y = cvt_pk_bf16(v0[2] * bflo(b.y), v0[3] * bfhi(b.y));
                    w.z = cvt_pk_bf16(v1[0] * bflo(b.z), v1[1] * bfhi(b.z)); w.w = cvt_pk_bf16(v1[2] * bflo(b.w), v1[3] * bfhi(b.w));
                    *(u32x4*)(MG + off + bj * HALF) = w; } }
    }
};

template <class Epi, class Sched>
__device__ __forceinline__ void gemm_simple(const Gemm g, const Sched& S, const Epi& E) {
    const int tid = threadIdx.x, wid = __builtin_amdgcn_readfirstlane(tid >> 6), lane = tid & 63, wr = wid >> 2, wc = wid & 3, fr = lane & 15, fq = lane >> 4;
    const int K = g.K; Unit cur;
    for (int ui = 0; S.next(ui, cur); ++ui) {
        f32x4 acc[2][2][4][2];
#pragma unroll
        for (int a = 0; a < 2; ++a)
#pragma unroll
            for (int b = 0; b < 2; ++b)
#pragma unroll
                for (int m = 0; m < 4; ++m)
#pragma unroll
                    for (int n = 0; n < 2; ++n) acc[a][b][m][n] = (f32x4){0.f, 0.f, 0.f, 0.f};
        const bf16_t* ap = g.A + (size_t)(cur.pm * BM + wr * 64 + fr) * K + 8 * fq;
        const bf16_t* bp[2];
#pragma unroll
        for (int n = 0; n < 2; ++n) bp[n] = g.Bt + (size_t)(cur.pn * BM + wc * 32 + (Epi::PERM ? perm32(16 * n + fr) : 16 * n + fr)) * K + 8 * fq;
        for (int t = 0; t < K / 32; ++t) {
            if constexpr (Epi::MID_T > 0) { if (t == 2 * Epi::MID_T) E.mid(acc, cur, wr, wc, fr, fq); }
            bf16x8 Af[2][4], Bf[2][2];
#pragma unroll
            for (int ai = 0; ai < 2; ++ai)
#pragma unroll
                for (int m = 0; m < 4; ++m) Af[ai][m] = *(const bf16x8*)(ap + (size_t)(ai * HALF + m * 16) * K + t * 32);
#pragma unroll
            for (int bj = 0; bj < 2; ++bj)
#pragma unroll
                for (int n = 0; n < 2; ++n) Bf[bj][n] = *(const bf16x8*)(bp[n] + (size_t)(bj * HALF) * K + t * 32);
#pragma unroll
            for (int ai = 0; ai < 2; ++ai)
#pragma unroll
                for (int bj = 0; bj < 2; ++bj)
#pragma unroll
                    for (int m = 0; m < 4; ++m)
#pragma unroll
                        for (int n = 0; n < 2; ++n) acc[ai][bj][m][n] = __builtin_amdgcn_mfma_f32_16x16x32_bf16(Bf[bj][n], Af[ai][m], acc[ai][bj][m][n], 0, 0, 0);
        }
        E(acc, cur, wr, wc, fr, fq);
    }
}

template <class Epi, class Sched, bool ALIGN_EPI = false, bool SP2 = false>
__device__ __forceinline__ void gemm_phase(PG8_LAS unsigned char* lds, const Gemm g, const Sched& S, const Epi& E) {
    const int tid = threadIdx.x, wid = __builtin_amdgcn_readfirstlane(tid >> 6), lane = tid & 63, wr = wid >> 2, wc = wid & 3, fr = lane & 15, fq = lane >> 4;
    const int K = g.K, nt = K / BK;
    unsigned voffA[2], voffB[2];
#pragma unroll
    for (int i = 0; i < 2; ++i) { int R, C; stage_rc(tid * 16 + i * 8192, R, C); const int Rb = Epi::PERM ? ((R & ~31) + perm32(R & 31)) : R;
        voffA[i] = (unsigned)(R * K + C) * 2u; voffB[i] = (unsigned)(Rb * K + C) * 2u; }
    const size_t kstep = (size_t)(BK * 2);
    const size_t hstep = (size_t)HALF * K * 2;
    const size_t tstep = 2 * hstep;
    const unsigned ldsw = (unsigned)wid * 1024u;
    const int aoff = lds_byte(wr * 64 + fr, fq * 8), boff = lds_byte(wc * 32 + fr, fq * 8);
#define PG8_SA(b, h) (((b) * 2 + (h)) * HTB)
#define PG8_SB(b, h) ((4 + (b) * 2 + (h)) * HTB)
#define PG8_STAGE(bufoff, gbase, voff) do { _Pragma("unroll") for (int _i = 0; _i < 2; ++_i) \
        __builtin_amdgcn_global_load_lds((const unsigned*)((const char*)(gbase) + (voff)[_i]), (PG8_LAS unsigned*)(lds + (bufoff) + ldsw + _i * 8192), 16, 0, 0); } while (0)
#define PG8_LDA(dst, b, h) do { _Pragma("unroll") for (int m = 0; m < 4; ++m) _Pragma("unroll") for (int k = 0; k < 2; ++k) dst[m][k] = *(const PG8_LAS bf16x8*)(lds + PG8_SA(b, h) + aoff + m * 2048 + k * 1024); } while (0)
#define PG8_LDB(dst, b, h) do { _Pragma("unroll") for (int n = 0; n < 2; ++n) _Pragma("unroll") for (int k = 0; k < 2; ++k) dst[n][k] = *(const PG8_LAS bf16x8*)(lds + PG8_SB(b, h) + boff + n * 2048 + k * 1024); } while (0)
#define PG8_MMA(ai, bj, At, Bt) do { __builtin_amdgcn_s_setprio(1); _Pragma("unroll") for (int m = 0; m < 4; ++m) _Pragma("unroll") for (int n = 0; n < 2; ++n) _Pragma("unroll") for (int k = 0; k < 2; ++k) \
        acc[ai][bj][m][n] = __builtin_amdgcn_mfma_f32_16x16x32_bf16(Bt[n][k], At[m][k], acc[ai][bj][m][n], 0, 0, 0); __builtin_amdgcn_s_setprio(0); } while (0)
#define PG8_WAIT_V(n) asm volatile("s_waitcnt vmcnt(" #n ")" ::: "memory")
#define PG8_WAIT_L(n) asm volatile("s_waitcnt lgkmcnt(" #n ")" ::: "memory")
#define PG8_BAR __builtin_amdgcn_s_barrier()
#define PG8_SCHED __builtin_amdgcn_sched_barrier(0)
    Unit cur, nxt; int ui = 0;
    if (!S.next(0, cur)) return;
    f32x4 acc[2][2][4][2];
#pragma unroll
    for (int a = 0; a < 2; ++a)
#pragma unroll
        for (int b = 0; b < 2; ++b)
#pragma unroll
            for (int m = 0; m < 4; ++m)
#pragma unroll
                for (int n = 0; n < 2; ++n) acc[a][b][m][n] = (f32x4){0.f, 0.f, 0.f, 0.f};
    bf16x8 At[4][2], B0[2][2], B1[2][2];
    const char* cA = (const char*)g.A + (size_t)cur.pm * tstep; const char* cB = (const char*)g.Bt + (size_t)cur.pn * tstep;
    S.a_ready(cur);
    if constexpr (SP2) {
        PG8_STAGE(PG8_SB(0, 0), cB, voffB); PG8_STAGE(PG8_SB(0, 1), cB + hstep, voffB); PG8_STAGE(PG8_SA(0, 0), cA, voffA); PG8_STAGE(PG8_SA(0, 1), cA + hstep, voffA);
        if (wr == 1) PG8_BAR;
        PG8_WAIT_V(2); PG8_BAR;
        PG8_STAGE(PG8_SB(1, 0), cB + kstep, voffB); PG8_STAGE(PG8_SA(1, 0), cA + kstep, voffA); PG8_STAGE(PG8_SB(1, 1), cB + hstep + kstep, voffB);
        PG8_WAIT_V(6); PG8_BAR;
    } else {
        PG8_STAGE(PG8_SB(0, 0), cB, voffB); PG8_STAGE(PG8_SA(0, 0), cA, voffA); PG8_STAGE(PG8_SB(0, 1), cB + hstep, voffB); PG8_STAGE(PG8_SA(0, 1), cA + hstep, voffA);
        if (wr == 1) PG8_BAR;
        PG8_WAIT_V(4); PG8_BAR;
        PG8_STAGE(PG8_SB(1, 0), cB + kstep, voffB); PG8_STAGE(PG8_SA(1, 0), cA + kstep, voffA); PG8_STAGE(PG8_SB(1, 1), cB + hstep + kstep, voffB);
        PG8_WAIT_V(6); PG8_BAR;
    }
    for (;;) {
        const bool has_next = S.next(ui + 1, nxt);
        const char* nA = has_next ? (const char*)g.A + (size_t)nxt.pm * tstep : cA; const char* nB = has_next ? (const char*)g.Bt + (size_t)nxt.pn * tstep : cB;
        for (int t = 0; t < nt; t += 2) {
            const bool last = (t == nt - 2);
            if constexpr (Epi::MID_T > 0) { if (t == Epi::MID_T) E.mid(acc, cur, wr, wc, fr, fq); }
            const char* a1 = cA + (size_t)(t + 1) * kstep;
            const char* a2 = last ? nA : cA + (size_t)(t + 2) * kstep; const char* b2 = last ? nB : cB + (size_t)(t + 2) * kstep;
            const char* a3 = a2 + kstep; const char* b3 = b2 + kstep;
            if (last && has_next) S.a_ready(nxt);
            if constexpr (SP2) {
            PG8_LDB(B0, 0, 0); PG8_LDB(B1, 0, 1); PG8_SCHED; PG8_LDA(At, 0, 0); PG8_STAGE(PG8_SA(1, 1), a1 + hstep, voffA);
            PG8_WAIT_V(8); PG8_WAIT_L(0); PG8_BAR; PG8_MMA(0, 0, At, B0); PG8_MMA(0, 1, At, B1); PG8_BAR; PG8_SCHED;
            PG8_LDA(At, 0, 1); PG8_STAGE(PG8_SB(0, 0), b2, voffB); PG8_STAGE(PG8_SB(0, 1), b2 + hstep, voffB); PG8_STAGE(PG8_SA(0, 0), a2, voffA);
            PG8_WAIT_V(8); PG8_WAIT_L(0); PG8_BAR; PG8_MMA(1, 0, At, B0); PG8_MMA(1, 1, At, B1); PG8_BAR; PG8_SCHED;
            PG8_LDB(B0, 1, 0); PG8_LDB(B1, 1, 1); PG8_SCHED; PG8_LDA(At, 1, 0); PG8_STAGE(PG8_SA(0, 1), a2 + hstep, voffA);
            PG8_WAIT_V(8); PG8_WAIT_L(0); PG8_BAR; PG8_MMA(0, 0, At, B0); PG8_MMA(0, 1, At, B1); PG8_BAR; PG8_SCHED;
            PG8_LDA(At, 1, 1); PG8_STAGE(PG8_SB(1, 0), b3, voffB); PG8_STAGE(PG8_SB(1, 1), b3 + hstep, voffB); PG8_STAGE(PG8_SA(1, 0), a3, voffA);
            PG8_WAIT_V(8); PG8_WAIT_L(0); PG8_BAR; PG8_MMA(1, 0, At, B0); PG8_MMA(1, 1, At, B1); PG8_BAR; PG8_SCHED;
            } else {
            PG8_LDB(B0, 0, 0); PG8_SCHED; PG8_LDA(At, 0, 0); PG8_STAGE(PG8_SA(1, 1), a1 + hstep, voffA);
            PG8_WAIT_L(8); PG8_BAR; PG8_WAIT_L(0); PG8_MMA(0, 0, At, B0); PG8_BAR; PG8_SCHED;
            PG8_LDB(B1, 0, 1); PG8_STAGE(PG8_SB(0, 0), b2, voffB);
            PG8_BAR; PG8_WAIT_L(0); PG8_MMA(0, 1, At, B1); PG8_BAR;
            PG8_LDA(At, 0, 1); PG8_STAGE(PG8_SA(0, 0), a2, voffA);
            PG8_BAR; PG8_WAIT_L(0); PG8_MMA(1, 0, At, B0); PG8_BAR; PG8_SCHED;
            PG8_STAGE(PG8_SB(0, 1), b2 + hstep, voffB);
            PG8_WAIT_V(6); PG8_BAR; PG8_MMA(1, 1, At, B1); PG8_BAR;
            PG8_LDB(B0, 1, 0); PG8_SCHED; PG8_LDA(At, 1, 0); PG8_STAGE(PG8_SA(0, 1), a2 + hstep, voffA);
            PG8_WAIT_L(8); PG8_BAR; PG8_WAIT_L(0); PG8_MMA(0, 0, At, B0); PG8_BAR; PG8_SCHED;
            PG8_LDB(B1, 1, 1); PG8_STAGE(PG8_SB(1, 0), b3, voffB);
            PG8_BAR; PG8_WAIT_L(0); PG8_MMA(0, 1, At, B1); PG8_BAR;
            PG8_LDA(At, 1, 1); PG8_STAGE(PG8_SA(1, 0), a3, voffA);
            PG8_BAR; PG8_WAIT_L(0); PG8_MMA(1, 0, At, B0); PG8_BAR; PG8_SCHED;
            PG8_STAGE(PG8_SB(1, 1), b3 + hstep, voffB);
            PG8_WAIT_V(6); PG8_BAR; PG8_MMA(1, 1, At, B1); PG8_BAR;
            }
        }
        if constexpr (ALIGN_EPI) { if (wr == 0) PG8_BAR; }
        if constexpr (!Epi::AFTER_DRAIN) { E(acc, cur, wr, wc, fr, fq); S.done(cur); }
        if (!has_next) break;
#pragma unroll
        for (int a = 0; a < 2; ++a)
#pragma unroll
            for (int b = 0; b < 2; ++b)
#pragma unroll
                for (int m = 0; m < 4; ++m)
#pragma unroll
                    for (int n = 0; n < 2; ++n) acc[a][b][m][n] = (f32x4){0.f, 0.f, 0.f, 0.f};
        cur = nxt; cA = nA; cB = nB; ++ui;
        if constexpr (ALIGN_EPI) { if (wr == 1) PG8_BAR; }
    }
    PG8_WAIT_V(0);
    if constexpr (!ALIGN_EPI) { if (wr == 0) PG8_BAR; }
    PG8_BAR;
    if constexpr (Epi::AFTER_DRAIN) { E.fused(acc, cur, wr, wc, fr, fq, lds, wid, lane); S.done(cur); }
#undef PG8_SA
#undef PG8_SB
#undef PG8_STAGE
#undef PG8_LDA
#undef PG8_LDB
#undef PG8_MMA
#undef PG8_WAIT_V
#undef PG8_WAIT_L
#undef PG8_BAR
#undef PG8_SCHED
}
}

constexpr int NWAVES = 8;
constexpr int NPH = 15;
#ifndef MK_SEGS
#define MK_SEGS {0, NPH}
#endif
constexpr int SEGS[] = MK_SEGS;
constexpr int N_LAUNCHES = (int)(sizeof(SEGS) / sizeof(int)) / 2;
static_assert(N_LAUNCHES >= 1 && N_LAUNCHES <= 16, "1..16 launch segments");

constexpr int CW_BAR = 4096;

constexpr int RING_OFF = 0, RING_BYTES = 131072;
constexpr int LDSCTL_OFF = RING_BYTES, MISC_OFF = LDSCTL_OFF + 320;
constexpr int SMP_OFF = RING_BYTES + 1024;
constexpr int LDS_BYTES = 147456;
static_assert(MISC_OFF + 128 <= SMP_OFF && SMP_OFF + 10240 <= LDS_BYTES, "LDS map");

#define RLX_AGENT __ATOMIC_RELAXED, __HIP_MEMORY_SCOPE_AGENT
#define LDS_WAIT() asm volatile("s_waitcnt lgkmcnt(0)" ::: "memory")
#define VM_WAIT() asm volatile("s_waitcnt vmcnt(0)" ::: "memory")

#define XB_TMO      128
#define XB_XCNT(j)  (256  + 64 * (j))
#define XB_XSUB(j)  (1280 + 64 * (j))
#define XB_XGEN(j)  (2304 + 64 * (j))
#define XB_TOP      3328
#define XB_TOPGEN   3392
#define XCD_BAR_WORDS 3456
#define XB_SPIN_CAP (1u << 18)

__device__ __forceinline__ unsigned xb_ld(unsigned* p)              { return __hip_atomic_load(p, __ATOMIC_RELAXED, __HIP_MEMORY_SCOPE_AGENT); }
__device__ __forceinline__ unsigned xb_add(unsigned* p, unsigned v) { return __hip_atomic_fetch_add(p, v, __ATOMIC_RELAXED, __HIP_MEMORY_SCOPE_AGENT); }
__device__ __forceinline__ unsigned xb_xcc_id() { return (unsigned)__builtin_amdgcn_s_getreg((3 << 11) | 20) & 0xFu; }
#define XB_SPIN(cond, bar) do { unsigned _sp = 0; while (cond) { __builtin_amdgcn_s_sleep(1); \
    if ((++_sp & 255u) == 0u) { if (xb_ld(&(bar)[XB_TMO])) break; if (_sp > XB_SPIN_CAP) { atomicAdd(&(bar)[XB_TMO], 1u); break; } } } } while (0)

struct XcdBarrier {
    unsigned* bar; unsigned x;
    volatile LAS unsigned* st;
};

__device__ __forceinline__ XcdBarrier xcd_barrier_post(unsigned* bar, volatile LAS unsigned* st) {
    XcdBarrier b; b.bar = bar; b.x = xb_xcc_id(); b.st = st;
    if (threadIdx.x == 0) (void)xb_add(&bar[XB_XCNT(b.x)], 1u);
    return b;
}
__device__ __forceinline__ void xcd_barrier_complete(unsigned* bar, unsigned x, unsigned& nloc, unsigned& nx) {
    const unsigned G = gridDim.x * gridDim.y * gridDim.z;
    unsigned sum, cnt, mine, sp = 0u;
    for (;;) {
        sum = 0u; cnt = 0u; mine = 0u;
#pragma unroll
        for (unsigned j = 0; j < 16; ++j) { const unsigned c = xb_ld(&bar[XB_XCNT(j)]); sum += c; cnt += (c > 0u) ? 1u : 0u; mine = (j == x) ? c : mine; }
        if (sum == G) break;
        __builtin_amdgcn_s_sleep(1);
        if ((++sp & 255u) == 0u) { if (xb_ld(&bar[XB_TMO])) break; if (sp > XB_SPIN_CAP) { atomicAdd(&bar[XB_TMO], 1u); break; } }
    }
    nloc = mine > 0u ? mine : 1u; nx = cnt > 0u ? cnt : 1u;
}

__device__ __forceinline__ void xcd_barrier(const XcdBarrier& b) {
    asm volatile("s_waitcnt vmcnt(0)" ::: "memory");
    __syncthreads();
    if (threadIdx.x == 0) {
        unsigned* bar = b.bar;
        __builtin_amdgcn_s_waitcnt(0);
        unsigned nloc = b.st[0], nx = b.st[1];
        if (nloc == 0u) { xcd_barrier_complete(bar, b.x, nloc, nx); b.st[0] = nloc; b.st[1] = nx; }
        const unsigned old = xb_add(&bar[XB_XSUB(b.x)], 1u);
        const unsigned gen = old / nloc;
        if (old + 1u == (gen + 1u) * nloc) {
            __builtin_amdgcn_fence(__ATOMIC_RELEASE, "agent");
            asm volatile("s_waitcnt vmcnt(0)" ::: "memory");
            const unsigned og = xb_add(&bar[XB_TOP], 1u);
            const unsigned tg = og / nx;
            if (og + 1u == (tg + 1u) * nx) xb_add(&bar[XB_TOPGEN], 1u);
            else XB_SPIN(xb_ld(&bar[XB_TOPGEN]) == tg, bar);
            __builtin_amdgcn_fence(__ATOMIC_ACQUIRE, "agent");
            xb_add(&bar[XB_XGEN(b.x)], 1u);
            asm volatile("s_waitcnt vmcnt(0)" ::: "memory");
        } else {
            XB_SPIN(xb_ld(&bar[XB_XGEN(b.x)]) == gen, bar);
            __builtin_amdgcn_fence(__ATOMIC_ACQUIRE, "agent");
            asm volatile("s_waitcnt vmcnt(0)" ::: "memory");
        }
    }
    __syncthreads();
}

__device__ __forceinline__ float wave_sum(float v) {
#pragma unroll
    for (int o = 1; o < 64; o <<= 1) v += __shfl_xor(v, o);
    return v;
}
__device__ __forceinline__ float wave_max(float v) {
#pragma unroll
    for (int o = 1; o < 64; o <<= 1) v = fmaxf(v, __shfl_xor(v, o));
    return v;
}
__device__ __forceinline__ unsigned offb(unsigned row, unsigned ch) { return 256u * row + 16u * (ch ^ (((row & 3u) << 2) | ((row >> 2) & 3u))); }
typedef short v4i16_t __attribute__((ext_vector_type(4)));
__device__ __forceinline__ s16x4 tr_read(LAS unsigned char* p) { return __builtin_bit_cast(s16x4, __builtin_amdgcn_ds_read_tr16_b64_v4i16((LAS v4i16_t*)p)); }
__device__ __forceinline__ int crow(int reg, int h) { return (reg & 3) + 8 * (reg >> 2) + 4 * h; }
#define MFMA32(a, b, c) __builtin_amdgcn_mfma_f32_32x32x16_bf16((a), (b), (c), 0, 0, 0)
#define MFMA16(a, b, c) __builtin_amdgcn_mfma_f32_16x16x32_bf16((a), (b), (c), 0, 0, 0)

struct Args { const float* in[23]; float* out; unsigned char* ws; int ph_lo, ph_hi, li, pad; };

__device__ __forceinline__ void p0_transpose_item(const float* W, int K, int N, bf16_t* WT, int ldt, int koff, int mode, LAS float* scr, int item, int lane) {
    const int nblk = N / 32, kb = item / nblk, nb = item % nblk, k0 = 64 * kb, n0 = 32 * nb;
#pragma unroll 8
    for (int i = 0; i < 32; ++i) { const int kk = 2 * i + (lane >> 5); scr[kk * 33 + (lane & 31)] = W[(size_t)(k0 + kk) * N + n0 + (lane & 31)]; }
    LDS_WAIT(); asm volatile("" ::: "memory");
    int rbase = n0;
    if (mode == 1) { const int j = n0 >= FF ? n0 - FF : n0; rbase = 256 * (j >> 7) + (j & 127) + (n0 >= FF ? 128 : 0); }
    const int c = lane & 7;
#pragma unroll
    for (int j = 0; j < 4; ++j) { const int n = (lane >> 3) + 8 * j; const LAS float* s = scr + (8 * c) * 33 + n;
        u32x4 o; o.x = cvt_pk_bf16(s[0 * 33], s[1 * 33]); o.y = cvt_pk_bf16(s[2 * 33], s[3 * 33]); o.z = cvt_pk_bf16(s[4 * 33], s[5 * 33]); o.w = cvt_pk_bf16(s[6 * 33], s[7 * 33]);
        *(u32x4*)(WT + (size_t)(rbase + n) * ldt + koff + k0 + 8 * c) = o; }
    LDS_WAIT(); asm volatile("" ::: "memory");
}
struct KvCopy {
    const float *c0, *c1, *c2; float* out;
    static constexpr int NJ = 4, HR0 = DB * 128 * 2, HR1 = DB * 512 * 2, HR2 = DB * 2048 * 2, WC0 = HR0 / NJ, WC1 = HR1 / NJ, WC2 = HR2 / NJ, WCT = WC0 + WC1 + WC2;
    __device__ __forceinline__ unsigned locate(int wck, int lane, const char*& src, char*& dst) const {
        const float* c; size_t ob; int L;
        if (wck < WC0) { c = c0; ob = O_KV0S; L = 128; } else if (wck < WC0 + WC1) { wck -= WC0; c = c1; ob = O_KV1S; L = 512; } else { wck -= WC0 + WC1; c = c2; ob = O_KV2S; L = 2048; }
        const size_t off = (size_t)wck * (NJ * 1024) + lane * 16 + 2048;
        src = (const char*)c + 2048 + off; dst = (char*)(out + ob) + off;
        unsigned mask = 0u;
#pragma unroll
        for (int j = 0; j < NJ; ++j) { const int hr = wck * NJ + j; if (wck < WC2 && (((hr >> 1) & (L - 1)) != L - 1)) mask |= 1u << j; }
        return mask;
    }
    __device__ __forceinline__ void run(int first, int j0, int j1, int wave, int lane) const {
        for (int j = j0; j < j1; j += 2) {
            const char *sa, *sb; char *da, *db;
            const int wa = first + wave + 8 * j, wb = wa + 8; const bool hb = j + 1 < j1;
            const unsigned ma = __builtin_amdgcn_readfirstlane(locate(wa, lane, sa, da)), mb = hb ? __builtin_amdgcn_readfirstlane(locate(wb, lane, sb, db)) : 0u;
            f32x4 va[NJ], vb[NJ];
#pragma unroll
            for (int q = 0; q < NJ; ++q) { if (ma & (1u << q)) va[q] = __builtin_nontemporal_load((const f32x4*)(sa + (q * 1024 - 2048))); if (mb & (1u << q)) vb[q] = __builtin_nontemporal_load((const f32x4*)(sb + (q * 1024 - 2048))); }
#pragma unroll
            for (int q = 0; q < NJ; ++q) { if (ma & (1u << q)) __builtin_nontemporal_store(va[q], (f32x4*)(da + (q * 1024 - 2048))); if (mb & (1u << q)) __builtin_nontemporal_store(vb[q], (f32x4*)(db + (q * 1024 - 2048))); }
        }
    }
};
constexpr int KV_PER_PHASE = KvCopy::WCT / 4, KV_PER_CU = KV_PER_PHASE / 256, KV_PER_WAVE = KV_PER_CU / 8;
static_assert(KV_PER_PHASE * 4 == KvCopy::WCT && KV_PER_CU * 256 == KV_PER_PHASE && KV_PER_WAVE * 8 == KV_PER_CU, "KV copy split");
template <int NBF>
__device__ __forceinline__ void skinny_dot(f32x4 (&acc)[NBF], const bf16_t* ap, const bf16_t* bp0, const bf16_t* bp1, int nsteps) {
    for (int s = 0; s < nsteps; s += 8) {
        bf16x8 a[8], b0[8], b1[8];
#pragma unroll
        for (int j = 0; j < 8; ++j) { a[j] = *(const bf16x8*)(ap + (s + j) * 32); b0[j] = *(const bf16x8*)(bp0 + (s + j) * 32); if (NBF > 1) b1[j] = *(const bf16x8*)(bp1 + (s + j) * 32); }
#pragma unroll
        for (int j = 0; j < 8; ++j) { acc[0] = MFMA16(b0[j], a[j], acc[0]); if (NBF > 1) acc[1] = MFMA16(b1[j], a[j], acc[1]); }
    }
}

__device__ __forceinline__ void norm_mod_rows(const float* X, const float* XSmp, const float* gain, const float* mod, int idx, bf16_t* XN, int gw, int NGW, int lane) {
    for (int blk = gw; blk < MP / 32 + DB; blk += NGW) {
        const bool smp = blk >= MP / 32;
        const int b = smp ? NB + (blk - MP / 32) : (blk >> 7);
        const float* mp = mod + (size_t)b * NADA + (3 * idx) * D;
        f32x4 ca[4], cs[4];
#pragma unroll
        for (int j = 0; j < 4; ++j) { const int col = 4 * lane + 256 * j; const f32x4 gg = *(const f32x4*)(gain + col), sc = *(const f32x4*)(mp + D + col); ca[j] = gg * (sc + 1.0f); cs[j] = *(const f32x4*)(mp + col); }
        const int nrows = smp ? 1 : 32;
        const float* src = smp ? XSmp + (size_t)(blk - MP / 32) * D : X + (size_t)blk * 32 * D;
        bf16_t* dst = XN + (smp ? (size_t)(MP + blk - MP / 32) : (size_t)blk * 32) * D;
        for (int rr = 0; rr < nrows; ++rr) {
            f32x4 v[4]; float ss = 0.f;
#pragma unroll
            for (int j = 0; j < 4; ++j) { v[j] = *(const f32x4*)(src + (size_t)rr * D + 4 * lane + 256 * j); ss += (v[j][0] * v[j][0] + v[j][1] * v[j][1]) + (v[j][2] * v[j][2] + v[j][3] * v[j][3]); }
            const float r = __builtin_amdgcn_rsqf(wave_sum(ss) * (1.0f / D) + EPS);
#pragma unroll
            for (int j = 0; j < 4; ++j) { const f32x4 o = v[j] * r * ca[j] + cs[j]; u32x2 w; w.x = cvt_pk_bf16(o[0], o[1]); w.y = cvt_pk_bf16(o[2], o[3]); *(u32x2*)(dst + (size_t)rr * D + 4 * lane + 256 * j) = w; }
        }
    }
}
__device__ __forceinline__ void final_norm_rows(float* Y, const float* XSmp, float* YS, const float* gain, int gw, int NGW, int lane) {
    f32x4 cg[4];
#pragma unroll
    for (int j = 0; j < 4; ++j) cg[j] = *(const f32x4*)(gain + 4 * lane + 256 * j);
    for (int blk = gw; blk < MP / 32 + DB; blk += NGW) {
        const bool smp = blk >= MP / 32;
        const int nrows = smp ? 1 : 32;
        const float* src = smp ? XSmp + (size_t)(blk - MP / 32) * D : Y + (size_t)blk * 32 * D;
        float* dst = smp ? YS + (size_t)(blk - MP / 32) * D : Y + (size_t)blk * 32 * D;
        for (int rr = 0; rr < nrows; ++rr) {
            f32x4 v[4]; float ss = 0.f;
#pragma unroll
            for (int j = 0; j < 4; ++j) { v[j] = *(const f32x4*)(src + (size_t)rr * D + 4 * lane + 256 * j); ss += (v[j][0] * v[j][0] + v[j][1] * v[j][1]) + (v[j][2] * v[j][2] + v[j][3] * v[j][3]); }
            const float r = __builtin_amdgcn_rsqf(wave_sum(ss) * (1.0f / D) + EPS);
#pragma unroll
            for (int j = 0; j < 4; ++j) *(f32x4*)(dst + (size_t)rr * D + 4 * lane + 256 * j) = v[j] * r * cg[j];
        }
    }
}

struct AttnUnit { int hp, g, b, dsh, r, n, head0; size_t tok0; };
__device__ __forceinline__ AttnUnit attn_decode(int unit) {
    AttnUnit a; a.hp = unit & 1; const int rn = (unit >> 1) & 31, gb = unit >> 6; a.g = gb % 3; a.b = gb / 3;
    a.dsh = 2 * a.g; const int dil = 1 << a.dsh; a.r = rn & (dil - 1); a.n = rn >> a.dsh; a.tok0 = (size_t)a.b * SEQ + a.r; a.head0 = 4 * a.g + 2 * a.hp; return a;
}
__device__ __forceinline__ void attn_load(const bf16_t* QKV, int unit, int tid, u32x4 (&kreg)[8], u32x4 (&vreg)[8]) {
    const AttnUnit a = attn_decode(unit);
    const int jj_lo = (a.n == 0) ? 128 : 0;
#pragma unroll
    for (int it = 0; it < 8; ++it) {
        const int cid = it * 512 + tid, row = cid >> 4, ch = cid & 15;
        if (row >= jj_lo) {
            const size_t tok = a.tok0 + ((size_t)((a.n - 1) * 128 + row) << a.dsh);
            const bf16_t* src = QKV + tok * 2304 + a.head0 * 64 + ch * 8;
            kreg[it] = *(const u32x4*)(src + DATT); vreg[it] = *(const u32x4*)(src + 2 * DATT);
        }
    }
}
__device__ __forceinline__ void attn_load_q(const bf16_t* QKV, int unit, int wave, int lane, bf16x8 (&qf)[4]) {
    const AttnUnit a = attn_decode(unit);
    const int hsel = wave >> 2, qsub = wave & 3, ql = lane & 31, h = lane >> 5;
    const size_t tokq = a.tok0 + ((size_t)(a.n * 128 + 32 * qsub + ql) << a.dsh);
    const bf16_t* qp = QKV + tokq * 2304 + (a.head0 + hsel) * 64 + 8 * h;
#pragma unroll
    for (int dc = 0; dc < 4; ++dc) qf[dc] = *(const bf16x8*)(qp + 16 * dc);
}
__device__ __forceinline__ void attn_write(LAS unsigned char* lds, int unit, int tid, const u32x4 (&kreg)[8], const u32x4 (&vreg)[8]) {
    const AttnUnit a = attn_decode(unit);
    const int jj_lo = (a.n == 0) ? 128 : 0;
    LAS unsigned char* Kimg = lds; LAS unsigned char* Vimg = lds + 65536;
#pragma unroll
    for (int it = 0; it < 8; ++it) {
        const int cid = it * 512 + tid, row = cid >> 4, ch = cid & 15;
        if (row >= jj_lo) { *(LAS u32x4*)(Kimg + offb(row, ch)) = kreg[it]; *(LAS u32x4*)(Vimg + offb(row, ch)) = vreg[it]; }
    }
}
__device__ __forceinline__ void attn_compute(LAS unsigned char* lds, bf16_t* AG, float* LSE, int unit, int wave, int lane, const bf16x8 (&qf)[4]) {
    const AttnUnit a = attn_decode(unit);
    const int n = a.n;
    LAS unsigned char* Kimg = lds; LAS unsigned char* Vimg = lds + 65536;
    const int hsel = wave >> 2, qsub = wave & 3, ql = lane & 31, h = lane >> 5;
    const int q4 = (lane & 15) >> 2, p4 = lane & 3, blk = (lane >> 4) & 1;
    const size_t tokq = a.tok0 + ((size_t)(n * 128 + 32 * qsub + ql) << a.dsh);
    const float cs = 0.125f * 1.44269504089f;
    f32x16 o0, o1;
#pragma unroll
    for (int i = 0; i < 16; ++i) { o0[i] = 0.f; o1[i] = 0.f; }
    float m = -INFINITY, l = 0.f;
#pragma unroll
    for (int tt = 0; tt < 5; ++tt) {
        const int jt = qsub + tt;
        if (!(n == 0 && jt < 4)) {
            f32x16 s;
#pragma unroll
            for (int i = 0; i < 16; ++i) s[i] = 0.f;
#pragma unroll
            for (int dc = 0; dc < 4; ++dc) { const bf16x8 kf = *(const LAS bf16x8*)(Kimg + offb(32 * jt + ql, hsel * 8 + 2 * dc + h)); s = MFMA32(kf, qf[dc], s); }
            float tm = -INFINITY;
#pragma unroll
            for (int i = 0; i < 16; ++i) { const int kr = crow(i, h); bool ok = true; if (tt == 0) ok = (kr >= ql); if (tt == 4) ok = (kr <= ql); s[i] = ok ? s[i] : -INFINITY; tm = fmaxf(tm, s[i]); }
            tm = fmaxf(tm, __shfl_xor(tm, 32));
            const float mn = fmaxf(m, tm), alpha = __builtin_amdgcn_exp2f((m - mn) * cs), mc = mn * cs;
            m = mn;
            float ps = 0.f;
#pragma unroll
            for (int i = 0; i < 16; ++i) { const float p = __builtin_amdgcn_exp2f(s[i] * cs - mc); s[i] = p; ps += p; }
            l = l * alpha + ps;
#pragma unroll
            for (int i = 0; i < 16; ++i) { o0[i] *= alpha; o1[i] *= alpha; }
#pragma unroll
            for (int ks = 0; ks < 2; ++ks) {
                u32x4 pw;
                pw.x = cvt_pk_bf16(s[8 * ks + 0], s[8 * ks + 1]); pw.y = cvt_pk_bf16(s[8 * ks + 2], s[8 * ks + 3]);
                pw.z = cvt_pk_bf16(s[8 * ks + 4], s[8 * ks + 5]); pw.w = cvt_pk_bf16(s[8 * ks + 6], s[8 * ks + 7]);
                const bf16x8 pf = __builtin_bit_cast(bf16x8, pw);
                const int row0 = 32 * jt + 16 * ks + 4 * h + q4;
#pragma unroll
                for (int c = 0; c < 2; ++c) {
                    const int chv = hsel * 8 + 4 * c + 2 * blk + (p4 >> 1);
                    const s16x4 lo = tr_read(Vimg + offb(row0, chv) + 8 * (p4 & 1)), hi = tr_read(Vimg + offb(row0 + 8, chv) + 8 * (p4 & 1));
                    const bf16x8 vf = __builtin_shufflevector(lo, hi, 0, 1, 2, 3, 4, 5, 6, 7);
                    if (c == 0) o0 = MFMA32(vf, pf, o0); else o1 = MFMA32(vf, pf, o1);
                }
            }
        }
    }
    l += __shfl_xor(l, 32);
    const float inv = 1.0f / l;
    bf16_t* op = AG + tokq * KAG + (a.head0 + hsel) * 64 + 4 * h;
#pragma unroll
    for (int gq = 0; gq < 4; ++gq) {
        u32x2 w0, w1;
        w0.x = cvt_pk_bf16(o0[4 * gq] * inv, o0[4 * gq + 1] * inv); w0.y = cvt_pk_bf16(o0[4 * gq + 2] * inv, o0[4 * gq + 3] * inv);
        w1.x = cvt_pk_bf16(o1[4 * gq] * inv, o1[4 * gq + 1] * inv); w1.y = cvt_pk_bf16(o1[4 * gq + 2] * inv, o1[4 * gq + 3] * inv);
        *(u32x2*)(op + 8 * gq) = w0; *(u32x2*)(op + 32 + 8 * gq) = w1;
    }
    if (h == 0) LSE[tokq * 12 + a.head0 + hsel] = m * 0.125f + __logf(l);
}
__device__ __forceinline__ void attn_prompt_phase(LAS unsigned char* lds, const bf16_t* QKV, bf16_t* AG, float* LSE, int vcu, int G, int tid, int wave, int lane) {
    constexpr int NU = NB * 3 * 32 * 2;
    u32x4 kreg[8], vreg[8]; bf16x8 qn[4], qc[4];
    int u = vcu;
    if (u < NU) { attn_load(QKV, u, tid, kreg, vreg); attn_load_q(QKV, u, wave, lane, qn); }
    while (u < NU) {
        attn_write(lds, u, tid, kreg, vreg);
#pragma unroll
        for (int dc = 0; dc < 4; ++dc) qc[dc] = qn[dc];
        __syncthreads();
        const int un = u + G;
        if (un < NU) { attn_load(QKV, un, tid, kreg, vreg); attn_load_q(QKV, un, wave, lane, qn); }
        attn_compute(lds, AG, LSE, u, wave, lane, qc);
        __syncthreads();
        u = un;
    }
}

__device__ __forceinline__ void gmlp_phase(LAS unsigned char* lds, const bf16_t* VB, const bf16_t* U, const bf16_t* WSP, const float* bsp, const float* lng, const float* lnb, bf16_t* AG, float* out,
                                           int vcu, int G, int wave, int lane) {
    const int grp = wave >> 1, ql = lane & 31, h = lane >> 5, q4 = (lane & 15) >> 2, p4 = lane & 3, blk = (lane >> 4) & 1;
    bf16x8 bw[20];
    {
        const bf16_t* wg = WSP + (size_t)grp * 128 * 128 + 8 * h;
        int idx = 0;
#pragma unroll
        for (int s = 0; s < 8; ++s)
#pragma unroll
            for (int it = s >> 1; it < 4; ++it) { bw[idx] = *(const bf16x8*)(wg + (size_t)(32 * it + ql) * 128 + 16 * s); ++idx; }
    }
    const f32x4 g0 = *(const f32x4*)(lng + 8 * lane), g1 = *(const f32x4*)(lng + 8 * lane + 4), b0 = *(const f32x4*)(lnb + 8 * lane), b1 = *(const f32x4*)(lnb + 8 * lane + 4);
    for (int unit = vcu; unit < NB * 32; unit += G) {
        const int b = unit >> 5, c = unit & 31;
        const size_t tokb = (size_t)b * SEQ + c * 128;
        {
            LAS unsigned char* img = lds + (lane >> 4) * 32768;
            u32x4 xr[16];
#pragma unroll
            for (int jr = 0; jr < 16; ++jr) xr[jr] = *(const u32x4*)(VB + (tokb + 16 * wave + jr) * DG + 8 * lane);
#pragma unroll
            for (int jr = 0; jr < 16; ++jr) {
                const int j = 16 * wave + jr; const u32x4 x = xr[jr];
                f32x4 v0, v1; v0[0] = bflo(x.x); v0[1] = bfhi(x.x); v0[2] = bflo(x.y); v0[3] = bfhi(x.y); v1[0] = bflo(x.z); v1[1] = bfhi(x.z); v1[2] = bflo(x.w); v1[3] = bfhi(x.w);
                const float mean = wave_sum((v0[0] + v0[1]) + (v0[2] + v0[3]) + (v1[0] + v1[1]) + (v1[2] + v1[3])) * (1.0f / DG);
                v0 = v0 - mean; v1 = v1 - mean;
                const float var = wave_sum((v0[0] * v0[0] + v0[1] * v0[1]) + (v0[2] * v0[2] + v0[3] * v0[3]) + (v1[0] * v1[0] + v1[1] * v1[1]) + (v1[2] * v1[2] + v1[3] * v1[3])) * (1.0f / DG);
                const float rstd = __builtin_amdgcn_rsqf(var + EPS);
                v0 = v0 * rstd * g0 + b0; v1 = v1 * rstd * g1 + b1;
                if (c == 31) { float* vo = out + O_VRP + ((size_t)b * 128 + j) * DG + 8 * lane; *(f32x4*)vo = v0; *(f32x4*)(vo + 4) = v1; }
                u32x4 w; w.x = cvt_pk_bf16(v0[0], v0[1]); w.y = cvt_pk_bf16(v0[2], v0[3]); w.z = cvt_pk_bf16(v1[0], v1[1]); w.w = cvt_pk_bf16(v1[2], v1[3]);
                *(LAS u32x4*)(img + offb(j, lane & 15)) = w;
            }
        }
        __syncthreads();
        LAS unsigned char* img = lds + grp * 32768;
#pragma unroll 1
        for (int cc = 0; cc < 2; ++cc) {
            const int c32 = (wave & 1) * 2 + cc;
            f32x16 acc[4];
#pragma unroll
            for (int it = 0; it < 4; ++it)
#pragma unroll
                for (int i = 0; i < 16; ++i) acc[it][i] = 0.f;
            const int chv = 4 * c32 + 2 * blk + (p4 >> 1);
            int idx = 0;
#pragma unroll
            for (int s = 0; s < 8; ++s) {
                const int row0 = 16 * s + 8 * h + q4;
                const s16x4 lo = tr_read(img + offb(row0, chv) + 8 * (p4 & 1)), hi = tr_read(img + offb(row0 + 4, chv) + 8 * (p4 & 1));
                const bf16x8 af = __builtin_shufflevector(lo, hi, 0, 1, 2, 3, 4, 5, 6, 7);
#pragma unroll
                for (int it = s >> 1; it < 4; ++it) { acc[it] = MFMA32(af, bw[idx], acc[it]); ++idx; }
            }
#pragma unroll
            for (int it = 0; it < 4; ++it) {
                const int i = 32 * it + ql; const float bias = bsp[grp * 128 + i];
                const size_t tok = tokb + i;
                const bf16_t* up = U + tok * DG + grp * 128 + 32 * c32 + 4 * h;
                bf16_t* gp = AG + tok * KAG + DATT + grp * 128 + 32 * c32 + 4 * h;
#pragma unroll
                for (int gq = 0; gq < 4; ++gq) { const u32x2 uu = *(const u32x2*)(up + 8 * gq);
                    u32x2 w; w.x = cvt_pk_bf16(bflo(uu.x) * (acc[it][4 * gq] + bias), bfhi(uu.x) * (acc[it][4 * gq + 1] + bias)); w.y = cvt_pk_bf16(bflo(uu.y) * (acc[it][4 * gq + 2] + bias), bfhi(uu.y) * (acc[it][4 * gq + 3] + bias));
                    *(u32x2*)(gp + 8 * gq) = w; }
            }
        }
        __syncthreads();
    }
}

__device__ __forceinline__ void sample_unit(LAS unsigned char* lds, const float* PROJS, const float* c0, const float* c1, const float* c2, const float* wsp, const float* bsp, const float* lng, const float* lnb,
                                            bf16_t* AG, float* out, int b, int tid, int wave, int lane) {
    LAS float* qs = (LAS float*)(lds + SMP_OFF) + wave * 64;
    LAS float* ps = (LAS float*)(lds + SMP_OFF + 2048) + wave * 128;
    LAS float* osh = (LAS float*)(lds + SMP_OFF + 6144);
    LAS float* lsv = (LAS float*)(lds + SMP_OFF + 9216);
    const float* pr = PROJS + (size_t)b * DIN;
#pragma unroll 1
    for (int head = wave; head < 12; head += 8) {
        const int g = head >> 2, hh = head & 3, dsh = 2 * g, L = 128 << dsh;
        const float* cg = (g == 0 ? c0 : (g == 1 ? c1 : c2)) + (size_t)b * L * 512;
        const float qv = pr[head * 64 + lane];
        qs[lane] = qv;
        LDS_WAIT(); asm volatile("" ::: "memory");
        float sc[2];
#pragma unroll
        for (int kk = 0; kk < 2; ++kk) {
            const float* kp = cg + ((size_t)(lane + 64 * kk) << dsh) * 512 + hh * 64;
            float d = 0.f;
#pragma unroll
            for (int j = 0; j < 16; ++j) { const f32x4 kv = *(const f32x4*)(kp + 4 * j); const f32x4 q4v = *(const LAS f32x4*)(qs + 4 * j); d += (kv[0] * q4v[0] + kv[1] * q4v[1]) + (kv[2] * q4v[2] + kv[3] * q4v[3]); }
            sc[kk] = d * 0.125f;
        }
        const float snew = wave_sum(qv * pr[DATT + head * 64 + lane]) * 0.125f;
        const float mx = wave_max(fmaxf(fmaxf(sc[0], sc[1]), snew));
        const float p0 = __expf(sc[0] - mx), p1 = __expf(sc[1] - mx), pn = __expf(snew - mx);
        const float l = wave_sum(p0 + p1) + pn;
        ps[lane] = p0; ps[lane + 64] = p1;
        LDS_WAIT(); asm volatile("" ::: "memory");
        {
            const int ks = lane >> 4, dq = lane & 15;
            const float* vp = cg + 256 + hh * 64 + 4 * dq;
            f32x4 o4 = (f32x4){0.f, 0.f, 0.f, 0.f};
            if (ks == 0) o4 = *(const f32x4*)(pr + 2 * DATT + head * 64 + 4 * dq) * pn;
#pragma unroll 8
            for (int it = 0; it < 32; ++it) { const int m = 4 * it + ks; o4 += *(const f32x4*)(vp + ((size_t)m << dsh) * 512) * ps[m]; }
#pragma unroll
            for (int e = 0; e < 4; ++e) { float t = o4[e]; t += __shfl_xor(t, 16); t += __shfl_xor(t, 32); o4[e] = t; }
            if (ks == 0) *(LAS f32x4*)(osh + head * 64 + 4 * dq) = o4 * (1.0f / l);
        }
        if (lane == 0) lsv[head] = mx + __logf(l);
        LDS_WAIT(); asm volatile("" ::: "memory");
    }
    __syncthreads();
    for (int t = tid; t < DATT; t += NWAVES * 64) {
        const int head = t >> 6, hh = head & 3, g = head >> 2;
        const float l0 = lsv[hh], l1 = lsv[4 + hh], l2 = lsv[8 + hh], m = fmaxf(l0, fmaxf(l1, l2));
        const float e0 = __expf(l0 - m), e1 = __expf(l1 - m), e2 = __expf(l2 - m);
        const float w = (g == 0 ? e0 : (g == 1 ? e1 : e2)) / (e0 + e1 + e2);
        AG[(size_t)(MP + b) * KAG + t] = (bf16_t)(cvt_pk_bf16(osh[t] * w, 0.f) & 0xffffu);
    }
    if (wave == 4) {
        const int grp = lane >> 4;
        f32x4 v0 = *(const f32x4*)(pr + 2816 + 8 * lane), v1 = *(const f32x4*)(pr + 2816 + 8 * lane + 4);
        const float mean = wave_sum((v0[0] + v0[1]) + (v0[2] + v0[3]) + (v1[0] + v1[1]) + (v1[2] + v1[3])) * (1.0f / DG);
        v0 = v0 - mean; v1 = v1 - mean;
        const float var = wave_sum((v0[0] * v0[0] + v0[1] * v0[1]) + (v0[2] * v0[2] + v0[3] * v0[3]) + (v1[0] * v1[0] + v1[1] * v1[1]) + (v1[2] * v1[2] + v1[3] * v1[3])) * (1.0f / DG);
        const float rstd = __builtin_amdgcn_rsqf(var + EPS);
        v0 = v0 * rstd * *(const f32x4*)(lng + 8 * lane) + *(const f32x4*)(lnb + 8 * lane); v1 = v1 * rstd * *(const f32x4*)(lng + 8 * lane + 4) + *(const f32x4*)(lnb + 8 * lane + 4);
        float* vo = out + O_VRS + (size_t)b * DG + 8 * lane; *(f32x4*)vo = v0; *(f32x4*)(vo + 4) = v1;
        const float w00 = wsp[(size_t)grp * 128 * 128], b00 = bsp[grp * 128];
        const f32x4 u0 = *(const f32x4*)(pr + 2304 + 8 * lane), u1 = *(const f32x4*)(pr + 2304 + 8 * lane + 4);
        const f32x4 m0 = u0 * (v0 * w00 + b00), m1 = u1 * (v1 * w00 + b00);
        u32x4 w; w.x = cvt_pk_bf16(m0[0], m0[1]); w.y = cvt_pk_bf16(m0[2], m0[3]); w.z = cvt_pk_bf16(m1[0], m1[1]); w.w = cvt_pk_bf16(m1[2], m1[3]);
        *(u32x4*)(AG + (size_t)(MP + b) * KAG + DATT + 8 * lane) = w;
    }
    __syncthreads();
}


#define INP(k) (args.in[k])
#define WSB(off) ((bf16_t*)(ws + (off)))
#define WSF(off) ((float*)(ws + (off)))
#define x_prompt INP(0)
#define x_sample INP(1)
#define c_prompt INP(2)
#define c_sample INP(3)
#define cache0 INP(4)
#define cache1 INP(5)
#define cache2 INP(6)
#define ada_w INP(7)
#define ada_b INP(8)
#define norm_g INP(9)
#define ffn1_up INP(10)
#define ffn1_down INP(11)
#define w_in INP(12)
#define w_ba INP(13)
#define w_bb INP(14)
#define w_out INP(15)
#define v_ln_g INP(16)
#define v_ln_b INP(17)
#define w_sp INP(18)
#define b_sp INP(19)
#define ffn2_up INP(20)
#define ffn2_down INP(21)
#define final_g INP(22)
#define W1U WSB(WS_W1U)
#define W1D WSB(WS_W1D)
#define WIN WSB(WS_WIN)
#define WAB WSB(WS_WAB)
#define WO WSB(WS_WO)
#define W2U WSB(WS_W2U)
#define W2D WSB(WS_W2D)
#define ADAW WSB(WS_ADAW)
#define AADA WSB(WS_AADA)
#define MOD WSF(WS_MOD)
#define WSP WSB(WS_WSP)
#define XS WSF(WS_XS)
#define PROJS WSF(WS_PROJS)
#define LSE WSF(WS_LSE)
#define XN WSB(WS_XN)
#define HB WSB(WS_H)
#define QKV WSB(WS_QKV)
#define UB WSB(WS_U)
#define VBB WSB(WS_VB)
#define SA WSB(WS_SA)
#define SB WSB(WS_SB)
#define AG WSB(WS_AG)
#define MG WSB(WS_MG)
#define YP (out + O_YP)
#define SH1 WSB(WS_SH1)
#define SH2 WSB(WS_SH2)
#define BIAS1 WSF(WS_BIAS1)
#define BIAS2 WSF(WS_BIAS2)
#define RSS1 WSF(WS_RSS1)
#define RSS2 WSF(WS_RSS2)
#define LANE_VARS() int tidv = threadIdx.x; asm volatile("" : "+v"(tidv)); const int lane = tidv & 63, fr = lane & 15, fq = lane >> 4; const size_t gt = (size_t)vcu * (NWAVES * 64) + tidv; (void)lane; (void)fr; (void)fq; (void)gt
__global__ void __launch_bounds__(NWAVES * 64, 2) fwd_kernel(Args args) {
    extern __shared__ __attribute__((aligned(16))) unsigned char lds_raw[];
    LAS unsigned char* lds = (LAS unsigned char*)lds_raw;
    const int tid = threadIdx.x, wave = __builtin_amdgcn_readfirstlane(tid >> 6);
    const int G = gridDim.x, bx = blockIdx.x;
    const int vcu = (G % 8 == 0) ? (bx % 8) * (G / 8) + bx / 8 : bx;
    const int gw = vcu * NWAVES + wave, NGW = G * NWAVES;
    const size_t NT = (size_t)G * (NWAVES * 64);
    unsigned char* ws = args.ws;
    unsigned* ctl = (unsigned*)(ws + WS_CTL);
    for (int u = tid; u < (LDS_BYTES - LDSCTL_OFF) / 4; u += NWAVES * 64) ((LAS unsigned*)(lds + LDSCTL_OFF))[u] = 0u;
    __syncthreads();
    volatile LAS unsigned* MISC = (volatile LAS unsigned*)(lds + MISC_OFF);
    XcdBarrier bar; bar.bar = ctl + CW_BAR; bar.x = 0; bar.st = nullptr;
    bar = xcd_barrier_post(ctl + CW_BAR + args.li * XCD_BAR_WORDS, MISC + 8);
#define GRID_BAR() xcd_barrier(bar)
    const int lo = args.ph_lo, hi = args.ph_hi;
#define IN(k) (lo <= (k) && (k) < hi)
#define BOTH(k) (IN(k) && IN((k) + 1))
    float* const out = args.out;
#define KV_BEFORE(KVQ) do { const KvCopy kc{cache0, cache1, cache2, out}; \
        if (G == 256) kc.run((KVQ) * KV_PER_PHASE + vcu * KV_PER_CU, 0, (KV_PER_WAVE * (vcu & 3)) / 3, wave, lane); \
        else for (int w0 = (KVQ) * KV_PER_PHASE + vcu * 8; w0 < ((KVQ) + 1) * KV_PER_PHASE; w0 += G * 8) kc.run(w0, 0, 1, wave, lane); } while (0)
#define KV_AFTER(KVQ) do { const KvCopy kc{cache0, cache1, cache2, out}; \
        if (G == 256) kc.run((KVQ) * KV_PER_PHASE + vcu * KV_PER_CU, (KV_PER_WAVE * (vcu & 3)) / 3, KV_PER_WAVE, wave, lane); } while (0)
#if SIMPLE_GEMM
#define RUN_GEMM(EPI, g, S, E) pg8::gemm_simple<EPI, pg8::StaticOrder>(g, S, E)
#else
#define RUN_GEMM(EPI, g, S, E) pg8::gemm_phase<EPI, pg8::StaticOrder, true, true>(lds + RING_OFF, g, S, E)
#endif

    if (IN(0)) {
        LANE_VARS();
        LAS float* scr = (LAS float*)(lds + RING_OFF + wave * 16384);
        constexpr int I_ADA = (D / 64) * (NADA / 32), I_UP = (D / 64) * (2 * FF / 32), I_DN = (FF / 64) * (D / 32), I_IN = (D / 64) * (DIN / 32), I_A = (DATT / 64) * (D / 32), I_B = (DG / 64) * (D / 32), I_O = (D / 64) * (D / 32);
        constexpr int NITEMS = I_ADA + 2 * I_UP + 2 * I_DN + I_IN + I_A + I_B + I_O;
        for (int it = gw; it < NITEMS; it += NGW) {
            int r = it;
            if (r < I_ADA) { p0_transpose_item(ada_w, D, NADA, ADAW, D, 0, 0, scr, r, lane); continue; } r -= I_ADA;
            if (r < I_UP) { p0_transpose_item(ffn1_up, D, 2 * FF, W1U, D, 0, 1, scr, r, lane); continue; } r -= I_UP;
            if (r < I_DN) { p0_transpose_item(ffn1_down, FF, D, W1D, FF, 0, 0, scr, r, lane); continue; } r -= I_DN;
            if (r < I_IN) { p0_transpose_item(w_in, D, DIN, WIN, D, 0, 0, scr, r, lane); continue; } r -= I_IN;
            if (r < I_A) { p0_transpose_item(w_ba, DATT, D, WAB, KAG, 0, 0, scr, r, lane); continue; } r -= I_A;
            if (r < I_B) { p0_transpose_item(w_bb, DG, D, WAB, KAG, DATT, 0, scr, r, lane); continue; } r -= I_B;
            if (r < I_O) { p0_transpose_item(w_out, D, D, WO, D, 0, 0, scr, r, lane); continue; } r -= I_O;
            if (r < I_UP) { p0_transpose_item(ffn2_up, D, 2 * FF, W2U, D, 0, 1, scr, r, lane); continue; } r -= I_UP;
            p0_transpose_item(ffn2_down, FF, D, W2D, FF, 0, 0, scr, r, lane);
        }
        for (size_t i = gt; i < (size_t)NMOD * D / 4; i += NT) {
            const f32x4 c = (i < (size_t)NB * D / 4) ? ((const f32x4*)c_prompt)[i] : ((const f32x4*)c_sample)[i - (size_t)NB * D / 4];
            u32x2 w; w.x = cvt_pk_bf16(siluf_(c[0]), siluf_(c[1])); w.y = cvt_pk_bf16(siluf_(c[2]), siluf_(c[3]));
            ((u32x2*)AADA)[i] = w;
        }
        for (size_t i = gt; i < 3 * D / 4; i += NT) ((f32x4*)WSF(WS_NG))[i] = ((const f32x4*)norm_g)[i];
        for (size_t i = gt; i < (size_t)4 * 128 * 128 / 4; i += NT) {
            const int j0 = (int)(i & 31) * 4, rr = (int)(i >> 5) & 127;
            const f32x4 v = ((const f32x4*)w_sp)[i];
            u32x2 w; w.x = cvt_pk_bf16(j0 <= rr ? v[0] : 0.f, j0 + 1 <= rr ? v[1] : 0.f); w.y = cvt_pk_bf16(j0 + 2 <= rr ? v[2] : 0.f, j0 + 3 <= rr ? v[3] : 0.f);
            ((u32x2*)WSP)[i] = w;
        }
        if (BOTH(0)) GRID_BAR();
    }

    if (IN(1)) {
        LANE_VARS();
        for (int it = vcu; it < NADA / 16; it += G)
            for (int rb = wave; rb < NMOD / 16; rb += NWAVES) {
                f32x4 acc[1]; acc[0] = (f32x4){0.f, 0.f, 0.f, 0.f};
                const bf16_t* bp = ADAW + (size_t)(16 * it + fr) * D + 8 * fq;
                skinny_dot<1>(acc, AADA + (size_t)(16 * rb + fr) * D + 8 * fq, bp, bp, D / 32);
                const int col = 16 * it + 4 * fq;
                const f32x4 mv = acc[0] + *(const f32x4*)(ada_b + col); *(f32x4*)(MOD + (size_t)(16 * rb + fr) * NADA + col) = mv;
                if ((col >= 3 * D && col < 4 * D) || (col >= 6 * D && col < 7 * D)) {
                    u32x2 w; w.x = cvt_pk_bf16(mv[0], mv[1]); w.y = cvt_pk_bf16(mv[2], mv[3]);
                    *(u32x2*)((col < 4 * D ? SH1 : SH2) + (size_t)(16 * rb + fr) * D + (col & (D - 1))) = w; }
            }
        if (BOTH(1)) GRID_BAR();
    }

    if (IN(2)) {
        LANE_VARS();
        for (int it = vcu; it < (DIN + 2 * FF) / 16; it += G) {
            const bool two = it >= DIN / 16; const int nb = two ? it - DIN / 16 : it, ncol = two ? 2 * FF : DIN;
            const bf16_t* wt = two ? W2U : WIN; const bf16_t* sh = two ? SH2 : SH1; float* bo = two ? BIAS2 : BIAS1;
            for (int rb = wave; rb < NMOD / 16; rb += NWAVES) {
                f32x4 acc[1]; acc[0] = (f32x4){0.f, 0.f, 0.f, 0.f};
                const bf16_t* bp = wt + (size_t)(16 * nb + fr) * D + 8 * fq;
                skinny_dot<1>(acc, sh + (size_t)(16 * rb + fr) * D + 8 * fq, bp, bp, D / 32);
                *(f32x4*)(bo + (size_t)(16 * rb + fr) * ncol + 16 * nb + 4 * fq) = acc[0];
            }
        }
        norm_mod_rows(x_prompt, x_sample, norm_g, MOD, 0, XN, gw, NGW, lane);
        if (BOTH(2)) GRID_BAR();
    }

#define FFN_UP_PHASE(WU, DEFN) do { \
        for (int it = vcu; it < FF / 16; it += G) {                                      \
            const int j0 = 16 * it, ra0 = 256 * (j0 >> 7) + (j0 & 127), ra = ra0 + fr, srow = 16 * wave + fr; \
            f32x4 acc[2]; acc[0] = (f32x4){0.f, 0.f, 0.f, 0.f}; acc[1] = acc[0]; \
            const size_t row = (size_t)MP + srow; \
            skinny_dot<2>(acc, XN + row * D + 8 * fq, (WU) + (size_t)ra * D + 8 * fq, (WU) + (size_t)(ra + 128) * D + 8 * fq, D / 32); \
            if (DEFN) { const float r = __builtin_amdgcn_rsqf(RSS2[row] * (1.0f / D) + EPS); const float* bp = BIAS2 + (size_t)(NB + srow) * (2 * FF) + ra0 + 4 * fq; \
                acc[0] = acc[0] * r + *(const f32x4*)bp; acc[1] = acc[1] * r + *(const f32x4*)(bp + 128); } \
            u32x2 w; w.x = cvt_pk_bf16(siluf_(acc[0][0]) * acc[1][0], siluf_(acc[0][1]) * acc[1][1]); w.y = cvt_pk_bf16(siluf_(acc[0][2]) * acc[1][2], siluf_(acc[0][3]) * acc[1][3]); \
            *(u32x2*)(HB + row * FF + j0 + 4 * fq) = w; } \
        pg8::Gemm g{XN, (WU), MP, 2 * FF, D}; pg8::StaticOrder S; S.init(MP, 2 * FF, G, bx); pg8::EpiUp<DEFN> E{ws}; \
        RUN_GEMM(pg8::EpiUp<DEFN>, g, S, E); } while (0)
#define SKINNY_RESID(BASES, GIDX, GS, NORMO, GAINP, SCIDX, RSSP) do { \
            const f32x4 gv = *(const f32x4*)(MOD + (size_t)(NB + srow) * NADA + (GIDX) * D + col) * (GS); \
            const f32x4 xv = *(const f32x4*)((BASES) + (size_t)srow * D + col) + gv * acc[0]; \
            *(f32x4*)(XS + (size_t)srow * D + col) = xv; \
            if (NORMO) { const f32x4 ca = *(const f32x4*)((GAINP) + col) * (*(const f32x4*)(MOD + (size_t)(NB + srow) * NADA + (SCIDX) * D + col) + 1.0f), xa = xv * ca; \
                u32x2 w; w.x = cvt_pk_bf16(xa[0], xa[1]); w.y = cvt_pk_bf16(xa[2], xa[3]); *(u32x2*)(XN + (size_t)(MP + srow) * D + col) = w; \
                float ss = (xv[0] * xv[0] + xv[1] * xv[1]) + (xv[2] * xv[2] + xv[3] * xv[3]); ss += __shfl_xor(ss, 16); ss += __shfl_xor(ss, 32); \
                if (fq == 0) atomicAdd((RSSP) + MP + srow, ss); } } while (0)
#define FFN_DOWN_PHASE(WD, BASEP, BASES, GIDX, NORMO, NIDX, GAINP, SCIDX, RSSP) do { \
        for (int it = vcu; it < D / 16; it += G) { \
            f32x4 acc[1]; acc[0] = (f32x4){0.f, 0.f, 0.f, 0.f}; \
            const int srow = 16 * wave + fr, col = 16 * it + 4 * fq; \
            const bf16_t* bp = (WD) + (size_t)(16 * it + fr) * FF + 8 * fq; \
            skinny_dot<1>(acc, HB + (size_t)(MP + srow) * FF + 8 * fq, bp, bp, FF / 32); \
            SKINNY_RESID(BASES, GIDX, 0.5f, NORMO, GAINP, SCIDX, RSSP); } \
        pg8::Gemm g{HB, (WD), MP, D, FF}; pg8::StaticOrder S; S.init(MP, D, G, bx); typedef pg8::EpiResid<NORMO, GIDX, 1, NIDX> EpiR; EpiR E{(BASEP), YP, ws}; \
        RUN_GEMM(EpiR, g, S, E); } while (0)

    if (IN(3)) { LANE_VARS(); FFN_UP_PHASE(W1U, false); if (BOTH(3)) GRID_BAR(); }
    if (IN(4)) { LANE_VARS(); KV_BEFORE(0); FFN_DOWN_PHASE(W1D, x_prompt, x_sample, 2, true, 1, norm_g + D, 4, RSS1); KV_AFTER(0); if (BOTH(4)) GRID_BAR(); }


    if (IN(6)) {
        LANE_VARS();
        for (int it = vcu; it < DIN / 16; it += G) {
            f32x4 acc[1]; acc[0] = (f32x4){0.f, 0.f, 0.f, 0.f};
            const int srow = 16 * wave + fr, col = 16 * it + 4 * fq;
            const bf16_t* bp = WIN + (size_t)(16 * it + fr) * D + 8 * fq;
            skinny_dot<1>(acc, XN + (size_t)(MP + srow) * D + 8 * fq, bp, bp, D / 32);
            acc[0] = acc[0] * __builtin_amdgcn_rsqf(RSS1[MP + srow] * (1.0f / D) + EPS) + *(const f32x4*)(BIAS1 + (size_t)(NB + srow) * DIN + col);
            *(f32x4*)(PROJS + (size_t)srow * DIN + col) = acc[0];
            if (col >= DATT && col < 3 * DATT) {
                const int isv = col >= 2 * DATT ? 1 : 0, cc = col - (isv ? 2 * DATT : DATT), g = cc >> 8, L = 128 << (2 * g);
                const size_t ob = (g == 0 ? O_KV0S : (g == 1 ? O_KV1S : O_KV2S)) + ((size_t)srow * L + (L - 1)) * 512 + isv * 256 + (cc & 255);
                *(f32x4*)(out + ob) = acc[0];
            }
        }
        pg8::Gemm g{XN, WIN, MP, DIN, D}; pg8::StaticOrder S; S.init(MP, DIN, G, bx); pg8::EpiProj E{ws, out};
        RUN_GEMM(pg8::EpiProj, g, S, E);
        if (BOTH(6)) GRID_BAR();
    }

    if (IN(7)) {
        LANE_VARS();
        attn_prompt_phase(lds + RING_OFF, QKV, AG, LSE, vcu, G, tidv, wave, lane);
        gmlp_phase(lds + RING_OFF, VBB, UB, WSP, b_sp, v_ln_g, v_ln_b, AG, out, vcu, G, wave, lane);
        for (int u = vcu; u < DB; u += G) sample_unit(lds, PROJS, cache0, cache1, cache2, w_sp, b_sp, v_ln_g, v_ln_b, AG, out, u, tidv, wave, lane);
        if (BOTH(7)) GRID_BAR();
    }

    if (IN(8)) {
        LANE_VARS();
        for (size_t i = gt; i < (size_t)MP * 96; i += NT) {
            const size_t t = i / 96; const int ch = (int)(i - t * 96), head = ch >> 3, hh = head & 3, g = head >> 2;
            const float l0 = LSE[t * 12 + hh], l1 = LSE[t * 12 + 4 + hh], l2 = LSE[t * 12 + 8 + hh], m = fmaxf(l0, fmaxf(l1, l2));
            const float e0 = __expf(l0 - m), e1 = __expf(l1 - m), e2 = __expf(l2 - m);
            const float w = (g == 0 ? e0 : (g == 1 ? e1 : e2)) / (e0 + e1 + e2);
            u32x4* p = (u32x4*)(AG + t * KAG + ch * 8); const u32x4 v = *p;
            u32x4 o; o.x = cvt_pk_bf16(bflo(v.x) * w, bfhi(v.x) * w); o.y = cvt_pk_bf16(bflo(v.y) * w, bfhi(v.y) * w); o.z = cvt_pk_bf16(bflo(v.z) * w, bfhi(v.z) * w); o.w = cvt_pk_bf16(bflo(v.w) * w, bfhi(v.w) * w);
            *p = o;
        }
        if (BOTH(8)) GRID_BAR();
    }

    if (IN(9)) {
        LANE_VARS();
        KV_BEFORE(1);
        for (int it = vcu; it < D / 16; it += G) {
            f32x4 a0[1], a1[1]; a0[0] = (f32x4){0.f, 0.f, 0.f, 0.f}; a1[0] = a0[0];
            const int srow = 16 * wave + fr, col = 16 * it + 4 * fq;
            const bf16_t* bp = WAB + (size_t)(16 * it + fr) * KAG + 8 * fq; const bf16_t* ap = AG + (size_t)(MP + srow) * KAG + 8 * fq;
            skinny_dot<1>(a0, ap, bp, bp, DATT / 32);
            skinny_dot<1>(a1, ap + DATT, bp + DATT, bp + DATT, DG / 32);
            const f32x4 ga = *(const f32x4*)(PROJS + (size_t)srow * DIN + 3328 + col), gb = *(const f32x4*)(PROJS + (size_t)srow * DIN + 4352 + col);
            u32x2 w; w.x = cvt_pk_bf16(sigmoidf_(ga[0]) * a0[0][0] + sigmoidf_(gb[0]) * a1[0][0], sigmoidf_(ga[1]) * a0[0][1] + sigmoidf_(gb[1]) * a1[0][1]);
            w.y = cvt_pk_bf16(sigmoidf_(ga[2]) * a0[0][2] + sigmoidf_(gb[2]) * a1[0][2], sigmoidf_(ga[3]) * a0[0][3] + sigmoidf_(gb[3]) * a1[0][3]);
            *(u32x2*)(MG + (size_t)(MP + srow) * D + col) = w;
        }
        pg8::Gemm g{AG, WAB, MP, D, KAG}; pg8::StaticOrder S; S.init(MP, D, G, bx); pg8::EpiMerge E{ws};
        RUN_GEMM(pg8::EpiMerge, g, S, E);
        KV_AFTER(1);
        if (BOTH(9)) GRID_BAR();
    }

    if (IN(10)) {
        LANE_VARS();
        KV_BEFORE(2);
        for (int it = vcu; it < D / 16; it += G) {
            f32x4 acc[1]; acc[0] = (f32x4){0.f, 0.f, 0.f, 0.f};
            const int srow = 16 * wave + fr, col = 16 * it + 4 * fq;
            const bf16_t* bp = WO + (size_t)(16 * it + fr) * D + 8 * fq;
            skinny_dot<1>(acc, MG + (size_t)(MP + srow) * D + 8 * fq, bp, bp, D / 32);
            SKINNY_RESID(XS, 5, 1.0f, true, norm_g + 2 * D, 7, RSS2);
        }
        pg8::Gemm g{MG, WO, MP, D, D}; pg8::StaticOrder S; S.init(MP, D, G, bx); typedef pg8::EpiResid<true, 5, 2, 2> EpiR; EpiR E{YP, YP, ws};
        RUN_GEMM(EpiR, g, S, E);
        KV_AFTER(2);
        if (BOTH(10)) GRID_BAR();
    }


    if (IN(12)) { LANE_VARS(); FFN_UP_PHASE(W2U, true); if (BOTH(12)) GRID_BAR(); }
    if (IN(13)) { LANE_VARS(); KV_BEFORE(3); FFN_DOWN_PHASE(W2D, YP, XS, 8, false, 1, norm_g, 0, RSS1); KV_AFTER(3); if (BOTH(13)) GRID_BAR(); }

    if (IN(14)) { LANE_VARS(); final_norm_rows(YP, XS, out + O_YS, final_g, gw, NGW, lane); }
#undef IN
#undef BOTH
}

extern "C" void kernel_launch(void* const* d_in, const int* in_sizes, int n_in, void* d_out, int out_size, void* d_ws, size_t ws_size, hipStream_t stream) {
    static int grid = 0;
    if (grid == 0) {
        if (n_in != 23 || in_sizes[0] != MP * D || (size_t)out_size != O_END || ws_size < WS_END) {
            fprintf(stderr, "kernel_launch: unexpected shapes: n_in %d, in0 %d, out %d, ws %zu (need %zu); nothing launched\n", n_in, n_in > 0 ? in_sizes[0] : -1, out_size, ws_size, (size_t)WS_END); grid = -1; return; }
        int dev = 0, cus = 0, per_cu = 0;
        if (hipGetDevice(&dev) != hipSuccess || hipDeviceGetAttribute(&cus, hipDeviceAttributeMultiprocessorCount, dev) != hipSuccess) { fprintf(stderr, "kernel_launch: device query failed\n"); grid = -1; return; }
        if (hipFuncSetAttribute((const void*)fwd_kernel, hipFuncAttributeMaxDynamicSharedMemorySize, LDS_BYTES) != hipSuccess) { fprintf(stderr, "kernel_launch: hipFuncSetAttribute failed\n"); grid = -1; return; }
        if (hipOccupancyMaxActiveBlocksPerMultiprocessor(&per_cu, (const void*)fwd_kernel, NWAVES * 64, LDS_BYTES) != hipSuccess || per_cu < 1)
            fprintf(stderr, "kernel_launch: note: occupancy query reports %d workgroups per CU\n", per_cu);
        (void)hipGetLastError();
        grid = cus;
    }
    if (grid < 0) return;
    if (hipMemsetAsync((char*)d_ws + WS_CTL, 0, CTL_ZERO_BYTES, stream) != hipSuccess) { fprintf(stderr, "kernel_launch: hipMemsetAsync failed\n"); return; }
    Args a{};
    for (int i = 0; i < 23; ++i) a.in[i] = (const float*)d_in[i];
    a.out = (float*)d_out; a.ws = (unsigned char*)d_ws;
    for (int li = 0; li < N_LAUNCHES; ++li) {
        a.ph_lo = SEGS[2 * li]; a.ph_hi = SEGS[2 * li + 1]; a.li = li; a.pad = 0;
        hipLaunchKernelGGL(fwd_kernel, dim3(grid), dim3(NWAVES * 64), LDS_BYTES, stream, a);
        const hipError_t le = hipPeekAtLastError();
        if (le != hipSuccess) { fprintf(stderr, "kernel_launch: launch %d failed: %s\n", li, hipGetErrorName(le)); break; }
    }
}
```

```cpp
#include <hip/hip_runtime.h>
#include <cstdio>
#include <cstdint>

#define LAS __attribute__((address_space(3)))
#define GAS __attribute__((address_space(1)))
typedef unsigned short bf16_t;
typedef short bf16x8 __attribute__((ext_vector_type(8)));
typedef short s16x4 __attribute__((ext_vector_type(4)));
typedef float f32x4 __attribute__((ext_vector_type(4)));
typedef float f32x2 __attribute__((ext_vector_type(2)));
typedef float f32x16 __attribute__((ext_vector_type(16)));
typedef unsigned u32x4 __attribute__((ext_vector_type(4)));
typedef unsigned u32x2 __attribute__((ext_vector_type(2)));
typedef GAS unsigned gu32;

#ifndef SIMPLE_GEMM
#define SIMPLE_GEMM 0
#endif

constexpr int D = 1024, NB = 16, SEQ = 4096, MP = NB * SEQ  , DB = 128  , MPAD = MP + 256;
constexpr int FF = 2816, DIN = 5376, DATT = 768, DG = 512, KAG = DATT + DG  , NADA = 9 * D;
constexpr int NMOD = NB + DB;
constexpr float EPS = 1e-6f;
constexpr size_t O_YP = 0, O_YS = 67108864, O_KV0P = 67239936, O_KV1P = 68288512, O_KV2P = 72482816, O_VRP = 89260032,
                 O_KV0S = 90308608, O_KV1S = 98697216, O_KV2S = 132251648, O_VRS = 266469376, O_END = 266534912;

constexpr size_t MiB = 1u << 20;
constexpr size_t WS_CTL = 0, CTL_ZERO_BYTES = 2 * MiB;
constexpr size_t WS_RSS1 = 1 * MiB, WS_RSS2 = 1 * MiB + 512 * 1024;
constexpr size_t WS_W1U = 2 * MiB, WS_W1D = 13 * MiB, WS_WIN = 19 * MiB, WS_WAB = 30 * MiB, WS_WO = 33 * MiB, WS_W2U = 35 * MiB, WS_W2D = 46 * MiB, WS_ADAW = 52 * MiB;
constexpr size_t WS_AADA = 70 * MiB;
constexpr size_t WS_NG = 70 * MiB + 512 * 1024;
constexpr size_t WS_MOD = 71 * MiB;
constexpr size_t WS_WSP = 77 * MiB;
constexpr size_t WS_XS = 78 * MiB;
constexpr size_t WS_PROJS = 79 * MiB;
constexpr size_t WS_LSE = 82 * MiB;
constexpr size_t WS_SH1 = 85 * MiB, WS_SH2 = 85 * MiB + 512 * 1024;
constexpr size_t WS_BIAS1 = 86 * MiB, WS_BIAS2 = 90 * MiB;
constexpr size_t WS_XN = 96 * MiB;
constexpr size_t WS_H = 226 * MiB;
constexpr size_t WS_QKV = 226 * MiB;
constexpr size_t WS_U = 514 * MiB;
constexpr size_t WS_VB = 580 * MiB;
constexpr size_t WS_SA = 644 * MiB, WS_SB = 772 * MiB;
constexpr size_t WS_AG = 900 * MiB;
constexpr size_t WS_MG = 1062 * MiB;
constexpr size_t WS_END = 1192 * MiB;
static_assert(WS_W1U + (size_t)2 * FF * D * 2 <= WS_W1D && WS_W1D + (size_t)D * FF * 2 <= WS_WIN && WS_WIN + (size_t)DIN * D * 2 <= WS_WAB && WS_WAB + (size_t)D * KAG * 2 <= WS_WO && WS_WO + (size_t)D * D * 2 <= WS_W2U, "ws map 1");
static_assert(WS_W2U + (size_t)2 * FF * D * 2 <= WS_W2D && WS_W2D + (size_t)D * FF * 2 <= WS_ADAW && WS_ADAW + (size_t)NADA * D * 2 <= WS_AADA && WS_MOD + (size_t)NMOD * NADA * 4 <= WS_WSP, "ws map 2");
static_assert((size_t)MPAD * 4 <= 512 * 1024 && WS_BIAS1 + (size_t)NMOD * DIN * 4 <= WS_BIAS2 && WS_BIAS2 + (size_t)NMOD * 2 * FF * 4 <= WS_XN, "ws map 6");
static_assert(WS_PROJS + (size_t)DB * DIN * 4 <= WS_LSE && WS_LSE + (size_t)MP * 12 * 4 <= WS_SH1 && WS_XN + (size_t)MPAD * D * 2 <= WS_H && WS_H + (size_t)MPAD * FF * 2 <= WS_VB, "ws map 3");
static_assert(WS_QKV + (size_t)MP * 2304 * 2 <= WS_U && WS_U + (size_t)MP * DG * 2 <= WS_VB && WS_VB + (size_t)MP * DG * 2 <= WS_SA && WS_SA + (size_t)MP * D * 2 <= WS_SB && WS_SB + (size_t)MP * D * 2 <= WS_AG, "ws map 4");
static_assert(WS_AG + (size_t)MPAD * KAG * 2 <= WS_MG && WS_MG + (size_t)MPAD * D * 2 <= WS_END, "ws map 5");

__device__ __forceinline__ unsigned cvt_pk_bf16(float lo, float hi) { unsigned r; asm volatile("v_cvt_pk_bf16_f32 %0, %1, %2" : "=v"(r) : "v"(lo), "v"(hi)); return r; }
__device__ __forceinline__ float bf2f(unsigned short b) { return __uint_as_float((unsigned)b << 16); }
__device__ __forceinline__ float bflo(unsigned w) { return __uint_as_float(w << 16); }
__device__ __forceinline__ float bfhi(unsigned w) { return __uint_as_float(w & 0xffff0000u); }
__device__ __forceinline__ float fast_rcp(float x) { return __builtin_amdgcn_rcpf(x); }
__device__ __forceinline__ float sigmoidf_(float x) { return fast_rcp(1.0f + __builtin_amdgcn_exp2f(-1.44269504089f * x)); }
__device__ __forceinline__ float siluf_(float x) { return x * sigmoidf_(x); }

namespace pg8 {
#define PG8_LAS __attribute__((address_space(3)))
constexpr int BM = 256, BK = 64, HALF = 128, HTB = HALF * BK * 2  , STAGE_BYTES = 8 * HTB, NXCD = 8, WGM = 8;

__host__ __device__ __forceinline__ int lds_byte(int r, int c) { const int st = (r >> 4) * 2 + (c >> 5), rr = r & 15, cc = c & 31, ob = rr * 64 + cc * 2; return st * 1024 + (ob ^ (((ob >> 9) & 1) << 5)); }
__host__ __device__ __forceinline__ void stage_rc(int b, int& R, int& C) { const int st = b / 1024, sb = b % 1024, swz = sb ^ (((sb >> 9) & 1) << 5); R = (st >> 1) * 16 + swz / 64; C = (st & 1) * 32 + (swz % 64) / 2; }
__host__ __device__ __forceinline__ int perm32(int rho) { const int n = rho >> 4, i = rho & 15; return 8 * (i >> 2) + 4 * n + (i & 3); }

struct Unit { int pm, pn; };
struct Gemm { const bf16_t* A; const bf16_t* Bt; int M, N, K; };

struct StaticOrder {
    int nM, nN, nwg, G, c;
    __host__ __device__ void init(int M, int N, int G_, int c_) { nM = M / BM; nN = N / BM; nwg = nM * nN; G = G_; c = c_; }
    __host__ __device__ bool next(int i, Unit& u) const {
        const long L = (long)i * G + c; if (L >= nwg) return false;
        int wgid = (int)L; { const int q = nwg / NXCD, r = nwg % NXCD, xcd = wgid % NXCD, off = wgid / NXCD; wgid = (xcd < r ? xcd * (q + 1) : r * (q + 1) + (xcd - r) * q) + off; }
        const int nig = WGM * nN, gid = wgid / nig, fm = gid * WGM, gsz = (nM - fm) < WGM ? (nM - fm) : WGM;
        u.pm = fm + ((wgid % nig) % gsz); u.pn = (wgid % nig) / gsz; return true;
    }
    __device__ __forceinline__ void a_ready(const Unit&) const {}
    __device__ __forceinline__ void done(const Unit&) const {}
};


template <bool DEF> struct EpiUp {
    static constexpr bool PERM = true, AFTER_DRAIN = false; static constexpr int MID_T = 0;
    unsigned char* ws;
    __device__ __forceinline__ void operator()(const f32x4 (&acc)[2][2][4][2], const Unit& u, int wr, int wc, int fr, int fq) const {
        const int row0 = u.pm * BM + wr * 64 + fr, col0 = u.pn * HALF + wc * 32 + 8 * fq;
        bf16_t* const H = (bf16_t*)(ws + WS_H); const float* const rss = (const float*)(ws + WS_RSS2); const float* const bias = (const float*)(ws + WS_BIAS2);
        f32x4 bv[2][2];
        if (DEF) { const float* bp = bias + (size_t)(u.pm >> 4) * (2 * FF) + u.pn * BM + wc * 32 + 8 * fq;
#pragma unroll
            for (int bj = 0; bj < 2; ++bj)
#pragma unroll
                for (int n = 0; n < 2; ++n) bv[bj][n] = *(const f32x4*)(bp + bj * HALF + 4 * n); }
        float rr[2][4];
        if (DEF) {
#pragma unroll
            for (int ai = 0; ai < 2; ++ai)
#pragma unroll
                for (int m = 0; m < 4; ++m) rr[ai][m] = rss[row0 + ai * HALF + m * 16]; }
#pragma unroll
        for (int ai = 0; ai < 2; ++ai)
#pragma unroll
            for (int m = 0; m < 4; ++m) {
                f32x4 a0 = acc[ai][0][m][0], a1 = acc[ai][0][m][1], b0 = acc[ai][1][m][0], b1 = acc[ai][1][m][1];
                if (DEF) { const float r = __builtin_amdgcn_rsqf(rr[ai][m] * (1.0f / D) + EPS);
                    a0 = a0 * r + bv[0][0]; a1 = a1 * r + bv[0][1]; b0 = b0 * r + bv[1][0]; b1 = b1 * r + bv[1][1]; }
                u32x4 w;
                w.x = cvt_pk_bf16(siluf_(a0[0]) * b0[0], siluf_(a0[1]) * b0[1]); w.y = cvt_pk_bf16(siluf_(a0[2]) * b0[2], siluf_(a0[3]) * b0[3]);
                w.z = cvt_pk_bf16(siluf_(a1[0]) * b1[0], siluf_(a1[1]) * b1[1]); w.w = cvt_pk_bf16(siluf_(a1[2]) * b1[2], siluf_(a1[3]) * b1[3]);
                *(u32x4*)(H + (size_t)(row0 + ai * HALF + m * 16) * FF + col0) = w;
            }
    }
};
template <bool NORMOUT, int GATE_IDX, int GS2, int NIDX> struct EpiResid {
    static constexpr bool PERM = true, AFTER_DRAIN = false; static constexpr int MID_T = 0;
    const float* base; float* out; unsigned char* ws;
    __device__ __forceinline__ void operator()(const f32x4 (&acc)[2][2][4][2], const Unit& u, int wr, int wc, int fr, int fq) const {
        const float* const mod = (const float*)(ws + WS_MOD); bf16_t* const xn = (bf16_t*)(ws + WS_XN); const float* const gain = (const float*)(ws + WS_NG) + NIDX * D;
        float* const rss = (float*)(ws + (NIDX == 1 ? WS_RSS1 : WS_RSS2)); constexpr int gate_idx = GATE_IDX, sc_idx = 3 * NIDX + 1; constexpr float gs = 0.5f * GS2;
        const int row0 = u.pm * BM + wr * 64 + fr, col0 = u.pn * BM + wc * 32 + 8 * fq;
        const float* mp = mod + (size_t)(u.pm >> 4) * NADA + col0;
        f32x4 gv[2][2], cav[2][2];
#pragma unroll
        for (int bj = 0; bj < 2; ++bj)
#pragma unroll
            for (int n = 0; n < 2; ++n) { gv[bj][n] = *(const f32x4*)(mp + gate_idx * D + bj * HALF + 4 * n) * gs;
                if (NORMOUT) cav[bj][n] = *(const f32x4*)(gain + col0 + bj * HALF + 4 * n) * (*(const f32x4*)(mp + sc_idx * D + bj * HALF + 4 * n) + 1.0f); }
#pragma unroll
        for (int hq = 0; hq < 4; ++hq) {
            const int ai = hq >> 1, m0 = (hq & 1) * 2;
            f32x4 bs[2][2][2];
#pragma unroll
            for (int mm = 0; mm < 2; ++mm)
#pragma unroll
                for (int bj = 0; bj < 2; ++bj) { const size_t off = (size_t)(row0 + ai * HALF + (m0 + mm) * 16) * D + col0 + bj * HALF; bs[mm][bj][0] = *(const f32x4*)(base + off); bs[mm][bj][1] = *(const f32x4*)(base + off + 4); }
#pragma unroll
            for (int mm = 0; mm < 2; ++mm) { const int m = m0 + mm, row = row0 + ai * HALF + m * 16; const size_t off = (size_t)row * D + col0; float ss = 0.f;
#pragma unroll
                for (int bj = 0; bj < 2; ++bj) {
                    const f32x4 o0 = bs[mm][bj][0] + gv[bj][0] * acc[ai][bj][m][0], o1 = bs[mm][bj][1] + gv[bj][1] * acc[ai][bj][m][1];
                    *(f32x4*)(out + off + bj * HALF) = o0; *(f32x4*)(out + off + bj * HALF + 4) = o1;
                    if (NORMOUT) { ss += (o0[0] * o0[0] + o0[1] * o0[1]) + (o0[2] * o0[2] + o0[3] * o0[3]) + (o1[0] * o1[0] + o1[1] * o1[1]) + (o1[2] * o1[2] + o1[3] * o1[3]);
                        const f32x4 x0 = o0 * cav[bj][0], x1 = o1 * cav[bj][1];
                        u32x4 w; w.x = cvt_pk_bf16(x0[0], x0[1]); w.y = cvt_pk_bf16(x0[2], x0[3]); w.z = cvt_pk_bf16(x1[0], x1[1]); w.w = cvt_pk_bf16(x1[2], x1[3]);
                        *(u32x4*)(xn + off + bj * HALF) = w; } }
                if (NORMOUT) { ss += __shfl_xor(ss, 16); ss += __shfl_xor(ss, 32); if (fq == 0) atomicAdd(rss + row, ss); } }
        }
    }
};
struct EpiProj {
    static constexpr bool PERM = true, AFTER_DRAIN = false; static constexpr int MID_T = 0;
    unsigned char* ws; float* out;
    __device__ __forceinline__ void operator()(f32x4 (&acc)[2][2][4][2], const Unit& u, int wr, int wc, int fr, int fq) const {
        const int pn = u.pn, row0 = u.pm * BM + wr * 64 + fr, c8 = wc * 32 + 8 * fq;
        bf16_t* const QKV = (bf16_t*)(ws + WS_QKV); bf16_t* const U = (bf16_t*)(ws + WS_U); bf16_t* const VB = (bf16_t*)(ws + WS_VB); bf16_t* const SA = (bf16_t*)(ws + WS_SA); bf16_t* const SB = (bf16_t*)(ws + WS_SB);
        const float* const rss = (const float*)(ws + WS_RSS1); const float* const bias = (const float*)(ws + WS_BIAS1);
        { const float* bp = bias + (size_t)(u.pm >> 4) * DIN + pn * BM + c8; f32x4 bv[2][2];
#pragma unroll
          for (int bj = 0; bj < 2; ++bj)
#pragma unroll
              for (int n = 0; n < 2; ++n) bv[bj][n] = *(const f32x4*)(bp + bj * HALF + 4 * n);
#pragma unroll
          for (int ai = 0; ai < 2; ++ai)
#pragma unroll
              for (int m = 0; m < 4; ++m) { const float r = __builtin_amdgcn_rsqf(rss[row0 + ai * HALF + m * 16] * (1.0f / D) + EPS);
#pragma unroll
                  for (int bj = 0; bj < 2; ++bj)
#pragma unroll
                      for (int n = 0; n < 2; ++n) acc[ai][bj][m][n] = acc[ai][bj][m][n] * r + bv[bj][n]; } }
        bf16_t* dst; int ld; bool sig = false;
        if (pn < 9) { dst = QKV + pn * BM; ld = 3 * DATT; }
        else if (pn < 11) { dst = U + (pn - 9) * BM; ld = DG; }
        else if (pn < 13) { dst = VB + (pn - 11) * BM; ld = DG; }
        else if (pn < 17) { dst = SA + (pn - 13) * BM; ld = D; sig = true; }
        else { dst = SB + (pn - 17) * BM; ld = D; sig = true; }
#pragma unroll
        for (int ai = 0; ai < 2; ++ai)
#pragma unroll
            for (int m = 0; m < 4; ++m) { bf16_t* rowp = dst + (size_t)(row0 + ai * HALF + m * 16) * ld + c8;
#pragma unroll
                for (int bj = 0; bj < 2; ++bj) { f32x4 v0 = acc[ai][bj][m][0], v1 = acc[ai][bj][m][1];
                    if (sig) {
#pragma unroll
                        for (int e = 0; e < 4; ++e) { v0[e] = sigmoidf_(v0[e]); v1[e] = sigmoidf_(v1[e]); } }
                    u32x4 w; w.x = cvt_pk_bf16(v0[0], v0[1]); w.y = cvt_pk_bf16(v0[2], v0[3]); w.z = cvt_pk_bf16(v1[0], v1[1]); w.w = cvt_pk_bf16(v1[2], v1[3]);
                    *(u32x4*)(rowp + bj * HALF) = w; } }
        if (pn >= 3 && pn < 9) {
            const int g = (pn - 3) % 3, isv = (pn >= 6) ? 1 : 0, win = 128 << (2 * g), b = u.pm >> 4, t0 = (u.pm & 15) * BM;
            if (t0 + BM > SEQ - win) {
                const size_t obase = (g == 0 ? O_KV0P : (g == 1 ? O_KV1P : O_KV2P)) + (size_t)b * win * 512 + isv * 256 + c8;
#pragma unroll
                for (int ai = 0; ai < 2; ++ai)
#pragma unroll
                    for (int m = 0; m < 4; ++m) { const int i = t0 + ai * HALF + wr * 64 + m * 16 + fr - (SEQ - win);
                        if (i >= 0) { float* p = out + obase + (size_t)i * 512;
#pragma unroll
                            for (int bj = 0; bj < 2; ++bj) { *(f32x4*)(p + bj * HALF) = acc[ai][bj][m][0]; *(f32x4*)(p + bj * HALF + 4) = acc[ai][bj][m][1]; } } }
            }
        }
    }
};
struct EpiMerge {
    static constexpr bool PERM = true, AFTER_DRAIN = false; static constexpr int MID_T = DATT / 64;
    unsigned char* ws;
    __device__ __forceinline__ void mid(f32x4 (&acc)[2][2][4][2], const Unit& u, int wr, int wc, int fr, int fq) const {
        const bf16_t* const SA = (const bf16_t*)(ws + WS_SA); const bf16_t* const SB = (const bf16_t*)(ws + WS_SB);
        int row0 = u.pm * BM + wr * 64 + fr; const int col0 = u.pn * BM + wc * 32 + 8 * fq;
        asm volatile("" : "+v"(row0));
#pragma unroll
        for (int ai = 0; ai < 2; ++ai) {
            u32x4 av[4][2], bv[4][2];
#pragma unroll
            for (int m = 0; m < 4; ++m)
#pragma unroll
                for (int bj = 0; bj < 2; ++bj) { const size_t off = (size_t)(row0 + ai * HALF + m * 16) * D + col0 + bj * HALF; av[m][bj] = *(const u32x4*)(SA + off); bv[m][bj] = *(const u32x4*)(SB + off); }
#pragma unroll
            for (int m = 0; m < 4; ++m)
#pragma unroll
                for (int bj = 0; bj < 2; ++bj) { const u32x4 a = av[m][bj], b = bv[m][bj];
                    f32x4 r0, r1;
                    r0[0] = bflo(a.x) * fast_rcp(bflo(b.x)); r0[1] = bfhi(a.x) * fast_rcp(bfhi(b.x)); r0[2] = bflo(a.y) * fast_rcp(bflo(b.y)); r0[3] = bfhi(a.y) * fast_rcp(bfhi(b.y));
                    r1[0] = bflo(a.z) * fast_rcp(bflo(b.z)); r1[1] = bfhi(a.z) * fast_rcp(bfhi(b.z)); r1[2] = bflo(a.w) * fast_rcp(bflo(b.w)); r1[3] = bfhi(a.w) * fast_rcp(bfhi(b.w));
                    acc[ai][bj][m][0] *= r0; acc[ai][bj][m][1] *= r1; }
        }
    }
    __device__ __forceinline__ void operator()(const f32x4 (&acc)[2][2][4][2], const Unit& u, int wr, int wc, int fr, int fq) const {
        const bf16_t* const SB = (const bf16_t*)(ws + WS_SB); bf16_t* const MG = (bf16_t*)(ws + WS_MG);
        const int row0 = u.pm * BM + wr * 64 + fr, col0 = u.pn * BM + wc * 32 + 8 * fq;
        u32x4 bv[2][4][2];
#pragma unroll
        for (int ai = 0; ai < 2; ++ai)
#pragma unroll
            for (int m = 0; m < 4; ++m)
#pragma unroll
                for (int bj = 0; bj < 2; ++bj) bv[ai][m][bj] = *(const u32x4*)(SB + (size_t)(row0 + ai * HALF + m * 16) * D + col0 + bj * HALF);
#pragma unroll
        for (int ai = 0; ai < 2; ++ai)
#pragma unroll
            for (int m = 0; m < 4; ++m) { const size_t off = (size_t)(row0 + ai * HALF + m * 16) * D + col0;
#pragma unroll
                for (int bj = 0; bj < 2; ++bj) { const u32x4 b = bv[ai][m][bj]; const f32x4 v0 = acc[ai][bj][m][0], v1 = acc[ai][bj][m][1];
                    u32x4 w; w.x = cvt_pk_bf16(v0[0] * bflo(b.x), v0[1] * bfhi(b.x)); w.y = cvt_pk_bf16(v0[2] * bflo(b.y), v0[3] * bfhi(b.y));
                    w.z = cvt_pk_bf16(v1[0] * bflo(b.z), v1[1] * bfhi(b.z)); w.w = cvt_pk_bf16(v1[2] * bflo(b.w), v1[3] * bfhi(b.w));
                    *(u32x4*)(MG + off + bj * HALF) = w; } }
    }
};

template <class Epi, class Sched>
__device__ __forceinline__ void gemm_simple(const Gemm g, const Sched& S, const Epi& E) {
    const int tid = threadIdx.x, wid = __builtin_amdgcn_readfirstlane(tid >> 6), lane = tid & 63, wr = wid >> 2, wc = wid & 3, fr = lane & 15, fq = lane >> 4;
    const int K = g.K; Unit cur;
    for (int ui = 0; S.next(ui, cur); ++ui) {
        f32x4 acc[2][2][4][2];
#pragma unroll
        for (int a = 0; a < 2; ++a)
#pragma unroll
            for (int b = 0; b < 2; ++b)
#pragma unroll
                for (int m = 0; m < 4; ++m)
#pragma unroll
                    for (int n = 0; n < 2; ++n) acc[a][b][m][n] = (f32x4){0.f, 0.f, 0.f, 0.f};
        const bf16_t* ap = g.A + (size_t)(cur.pm * BM + wr * 64 + fr) * K + 8 * fq;
        const bf16_t* bp[2];
#pragma unroll
        for (int n = 0; n < 2; ++n) bp[n] = g.Bt + (size_t)(cur.pn * BM + wc * 32 + (Epi::PERM ? perm32(16 * n + fr) : 16 * n + fr)) * K + 8 * fq;
        for (int t = 0; t < K / 32; ++t) {
            if constexpr (Epi::MID_T > 0) { if (t == 2 * Epi::MID_T) E.mid(acc, cur, wr, wc, fr, fq); }
            bf16x8 Af[2][4], Bf[2][2];
#pragma unroll
            for (int ai = 0; ai < 2; ++ai)
#pragma unroll
                for (int m = 0; m < 4; ++m) Af[ai][m] = *(const bf16x8*)(ap + (size_t)(ai * HALF + m * 16) * K + t * 32);
#pragma unroll
            for (int bj = 0; bj < 2; ++bj)
#pragma unroll
                for (int n = 0; n < 2; ++n) Bf[bj][n] = *(const bf16x8*)(bp[n] + (size_t)(bj * HALF) * K + t * 32);
#pragma unroll
            for (int ai = 0; ai < 2; ++ai)
#pragma unroll
                for (int bj = 0; bj < 2; ++bj)
#pragma unroll
                    for (int m = 0; m < 4; ++m)
#pragma unroll
                        for (int n = 0; n < 2; ++n) acc[ai][bj][m][n] = __builtin_amdgcn_mfma_f32_16x16x32_bf16(Bf[bj][n], Af[ai][m], acc[ai][bj][m][n], 0, 0, 0);
        }
        E(acc, cur, wr, wc, fr, fq);
    }
}

template <class Epi, class Sched, bool ALIGN_EPI = false, bool SP2 = false>
__device__ __forceinline__ void gemm_phase(PG8_LAS unsigned char* lds, const Gemm g, const Sched& S, const Epi& E) {
    const int tid = threadIdx.x, wid = __builtin_amdgcn_readfirstlane(tid >> 6), lane = tid & 63, wr = wid >> 2, wc = wid & 3, fr = lane & 15, fq = lane >> 4;
    const int K = g.K, nt = K / BK;
    unsigned voffA[2], voffB[2];
#pragma unroll
    for (int i = 0; i < 2; ++i) { int R, C; stage_rc(tid * 16 + i * 8192, R, C); const int Rb = Epi::PERM ? ((R & ~31) + perm32(R & 31)) : R;
        voffA[i] = (unsigned)(R * K + C) * 2u; voffB[i] = (unsigned)(Rb * K + C) * 2u; }
    const size_t kstep = (size_t)(BK * 2);
    const size_t hstep = (size_t)HALF * K * 2;
    const size_t tstep = 2 * hstep;
    const unsigned ldsw = (unsigned)wid * 1024u;
    const int aoff = lds_byte(wr * 64 + fr, fq * 8), boff = lds_byte(wc * 32 + fr, fq * 8);
#define PG8_SA(b, h) (((b) * 2 + (h)) * HTB)
#define PG8_SB(b, h) ((4 + (b) * 2 + (h)) * HTB)
#define PG8_STAGE(bufoff, gbase, voff) do { _Pragma("unroll") for (int _i = 0; _i < 2; ++_i) \
        __builtin_amdgcn_global_load_lds((const unsigned*)((const char*)(gbase) + (voff)[_i]), (PG8_LAS unsigned*)(lds + (bufoff) + ldsw + _i * 8192), 16, 0, 0); } while (0)
#define PG8_LDA(dst, b, h) do { _Pragma("unroll") for (int m = 0; m < 4; ++m) _Pragma("unroll") for (int k = 0; k < 2; ++k) dst[m][k] = *(const PG8_LAS bf16x8*)(lds + PG8_SA(b, h) + aoff + m * 2048 + k * 1024); } while (0)
#define PG8_LDB(dst, b, h) do { _Pragma("unroll") for (int n = 0; n < 2; ++n) _Pragma("unroll") for (int k = 0; k < 2; ++k) dst[n][k] = *(const PG8_LAS bf16x8*)(lds + PG8_SB(b, h) + boff + n * 2048 + k * 1024); } while (0)
#define PG8_MMA(ai, bj, At, Bt) do { __builtin_amdgcn_s_setprio(1); _Pragma("unroll") for (int m = 0; m < 4; ++m) _Pragma("unroll") for (int n = 0; n < 2; ++n) _Pragma("unroll") for (int k = 0; k < 2; ++k) \
        acc[ai][bj][m][n] = __builtin_amdgcn_mfma_f32_16x16x32_bf16(Bt[n][k], At[m][k], acc[ai][bj][m][n], 0, 0, 0); __builtin_amdgcn_s_setprio(0); } while (0)
#define PG8_WAIT_V(n) asm volatile("s_waitcnt vmcnt(" #n ")" ::: "memory")
#define PG8_WAIT_L(n) asm volatile("s_waitcnt lgkmcnt(" #n ")" ::: "memory")
#define PG8_BAR __builtin_amdgcn_s_barrier()
#define PG8_SCHED __builtin_amdgcn_sched_barrier(0)
    Unit cur, nxt; int ui = 0;
    if (!S.next(0, cur)) return;
    f32x4 acc[2][2][4][2];
#pragma unroll
    for (int a = 0; a < 2; ++a)
#pragma unroll
        for (int b = 0; b < 2; ++b)
#pragma unroll
            for (int m = 0; m < 4; ++m)
#pragma unroll
                for (int n = 0; n < 2; ++n) acc[a][b][m][n] = (f32x4){0.f, 0.f, 0.f, 0.f};
    bf16x8 At[4][2], B0[2][2], B1[2][2];
    const char* cA = (const char*)g.A + (size_t)cur.pm * tstep; const char* cB = (const char*)g.Bt + (size_t)cur.pn * tstep;
    S.a_ready(cur);
    if constexpr (SP2) {
        PG8_STAGE(PG8_SB(0, 0), cB, voffB); PG8_STAGE(PG8_SB(0, 1), cB + hstep, voffB); PG8_STAGE(PG8_SA(0, 0), cA, voffA); PG8_STAGE(PG8_SA(0, 1), cA + hstep, voffA);
        if (wr == 1) PG8_BAR;
        PG8_WAIT_V(2); PG8_BAR;
        PG8_STAGE(PG8_SB(1, 0), cB + kstep, voffB); PG8_STAGE(PG8_SA(1, 0), cA + kstep, voffA); PG8_STAGE(PG8_SB(1, 1), cB + hstep + kstep, voffB);
        PG8_WAIT_V(6); PG8_BAR;
    } else {
        PG8_STAGE(PG8_SB(0, 0), cB, voffB); PG8_STAGE(PG8_SA(0, 0), cA, voffA); PG8_STAGE(PG8_SB(0, 1), cB + hstep, voffB); PG8_STAGE(PG8_SA(0, 1), cA + hstep, voffA);
        if (wr == 1) PG8_BAR;
        PG8_WAIT_V(4); PG8_BAR;
        PG8_STAGE(PG8_SB(1, 0), cB + kstep, voffB); PG8_STAGE(PG8_SA(1, 0), cA + kstep, voffA); PG8_STAGE(PG8_SB(1, 1), cB + hstep + kstep, voffB);
        PG8_WAIT_V(6); PG8_BAR;
    }
    for (;;) {
        const bool has_next = S.next(ui + 1, nxt);
        const char* nA = has_next ? (const char*)g.A + (size_t)nxt.pm * tstep : cA; const char* nB = has_next ? (const char*)g.Bt + (size_t)nxt.pn * tstep : cB;
        for (int t = 0; t < nt; t += 2) {
            const bool last = (t == nt - 2);
            if constexpr (Epi::MID_T > 0) { if (t == Epi::MID_T) E.mid(acc, cur, wr, wc, fr, fq); }
            const char* a1 = cA + (size_t)(t + 1) * kstep;
            const char* a2 = last ? nA : cA + (size_t)(t + 2) * kstep; const char* b2 = last ? nB : cB + (size_t)(t + 2) * kstep;
            const char* a3 = a2 + kstep; const char* b3 = b2 + kstep;
            if (last && has_next) S.a_ready(nxt);
            if constexpr (SP2) {
            PG8_LDB(B0, 0, 0); PG8_LDB(B1, 0, 1); PG8_SCHED; PG8_LDA(At, 0, 0); PG8_STAGE(PG8_SA(1, 1), a1 + hstep, voffA);
            PG8_WAIT_V(8); PG8_WAIT_L(0); PG8_BAR; PG8_MMA(0, 0, At, B0); PG8_MMA(0, 1, At, B1); PG8_BAR; PG8_SCHED;
            PG8_LDA(At, 0, 1); PG8_STAGE(PG8_SB(0, 0), b2, voffB); PG8_STAGE(PG8_SB(0, 1), b2 + hstep, voffB); PG8_STAGE(PG8_SA(0, 0), a2, voffA);
            PG8_WAIT_V(8); PG8_WAIT_L(0); PG8_BAR; PG8_MMA(1, 0, At, B0); PG8_MMA(1, 1, At, B1); PG8_BAR; PG8_SCHED;
            PG8_LDB(B0, 1, 0); PG8_LDB(B1, 1, 1); PG8_SCHED; PG8_LDA(At, 1, 0); PG8_STAGE(PG8_SA(0, 1), a2 + hstep, voffA);
            PG8_WAIT_V(8); PG8_WAIT_L(0); PG8_BAR; PG8_MMA(0, 0, At, B0); PG8_MMA(0, 1, At, B1); PG8_BAR; PG8_SCHED;
            PG8_LDA(At, 1, 1); PG8_STAGE(PG8_SB(1, 0), b3, voffB); PG8_STAGE(PG8_SB(1, 1), b3 + hstep, voffB); PG8_STAGE(PG8_SA(1, 0), a3, voffA);
            PG8_WAIT_V(8); PG8_WAIT_L(0); PG8_BAR; PG8_MMA(1, 0, At, B0); PG8_MMA(1, 1, At, B1); PG8_BAR; PG8_SCHED;
            } else {
            PG8_LDB(B0, 0, 0); PG8_SCHED; PG8_LDA(At, 0, 0); PG8_STAGE(PG8_SA(1, 1), a1 + hstep, voffA);
            PG8_WAIT_L(8); PG8_BAR; PG8_WAIT_L(0); PG8_MMA(0, 0, At, B0); PG8_BAR; PG8_SCHED;
            PG8_LDB(B1, 0, 1); PG8_STAGE(PG8_SB(0, 0), b2, voffB);
            PG8_BAR; PG8_WAIT_L(0); PG8_MMA(0, 1, At, B1); PG8_BAR;
            PG8_LDA(At, 0, 1); PG8_STAGE(PG8_SA(0, 0), a2, voffA);
            PG8_BAR; PG8_WAIT_L(0); PG8_MMA(1, 0, At, B0); PG8_BAR; PG8_SCHED;
            PG8_STAGE(PG8_SB(0, 1), b2 + hstep, voffB);
            PG8_WAIT_V(6); PG8_BAR; PG8_MMA(1, 1, At, B1); PG8_BAR;
            PG8_LDB(B0, 1, 0); PG8_SCHED; PG8_LDA(At, 1, 0); PG8_STAGE(PG8_SA(0, 1), a2 + hstep, voffA);
            PG8_WAIT_L(8); PG8_BAR; PG8_WAIT_L(0); PG8_MMA(0, 0, At, B0); PG8_BAR; PG8_SCHED;
            PG8_LDB(B1, 1, 1); PG8_STAGE(PG8_SB(1, 0), b3, voffB);
            PG8_BAR; PG8_WAIT_L(0); PG8_MMA(0, 1, At, B1); PG8_BAR;
            PG8_LDA(At, 1, 1); PG8_STAGE(PG8_SA(1, 0), a3, voffA);
            PG8_BAR; PG8_WAIT_L(0); PG8_MMA(1, 0, At, B0); PG8_BAR; PG8_SCHED;
            PG8_STAGE(PG8_SB(1, 1), b3 + hstep, voffB);
            PG8_WAIT_V(6); PG8_BAR; PG8_MMA(1, 1, At, B1); PG8_BAR;
            }
        }
        if constexpr (ALIGN_EPI) { if (wr == 0) PG8_BAR; }
        if constexpr (!Epi::AFTER_DRAIN) { E(acc, cur, wr, wc, fr, fq); S.done(cur); }
        if (!has_next) break;
#pragma unroll
        for (int a = 0; a < 2; ++a)
#pragma unroll
            for (int b = 0; b < 2; ++b)
#pragma unroll
                for (int m = 0; m < 4; ++m)
#pragma unroll
                    for (int n = 0; n < 2; ++n) acc[a][b][m][n] = (f32x4){0.f, 0.f, 0.f, 0.f};
        cur = nxt; cA = nA; cB = nB; ++ui;
        if constexpr (ALIGN_EPI) { if (wr == 1) PG8_BAR; }
    }
    PG8_WAIT_V(0);
    if constexpr (!ALIGN_EPI) { if (wr == 0) PG8_BAR; }
    PG8_BAR;
    if constexpr (Epi::AFTER_DRAIN) { E.fused(acc, cur, wr, wc, fr, fq, lds, wid, lane); S.done(cur); }
#undef PG8_SA
#undef PG8_SB
#undef PG8_STAGE
#undef PG8_LDA
#undef PG8_LDB
#undef PG8_MMA
#undef PG8_WAIT_V
#undef PG8_WAIT_L
#undef PG8_BAR
#undef PG8_SCHED
}
}

constexpr int NWAVES = 8;
constexpr int NPH = 15;
#ifndef MK_SEGS
#define MK_SEGS {0, NPH}
#endif
constexpr int SEGS[] = MK_SEGS;
constexpr int N_LAUNCHES = (int)(sizeof(SEGS) / sizeof(int)) / 2;
static_assert(N_LAUNCHES >= 1 && N_LAUNCHES <= 16, "1..16 launch segments");

constexpr int CW_BAR = 4096;

constexpr int RING_OFF = 0, RING_BYTES = 131072;
constexpr int LDSCTL_OFF = RING_BYTES, MISC_OFF = LDSCTL_OFF + 320;
constexpr int SMP_OFF = RING_BYTES + 1024;
constexpr int LDS_BYTES = 147456;
static_assert(MISC_OFF + 128 <= SMP_OFF && SMP_OFF + 10240 <= LDS_BYTES, "LDS map");

#define RLX_AGENT __ATOMIC_RELAXED, __HIP_MEMORY_SCOPE_AGENT
#define LDS_WAIT() asm volatile("s_waitcnt lgkmcnt(0)" ::: "memory")
#define VM_WAIT() asm volatile("s_waitcnt vmcnt(0)" ::: "memory")

#define XB_TMO      128
#define XB_XCNT(j)  (256  + 64 * (j))
#define XB_XSUB(j)  (1280 + 64 * (j))
#define XB_XGEN(j)  (2304 + 64 * (j))
#define XB_TOP      3328
#define XB_TOPGEN   3392
#define XCD_BAR_WORDS 3456
#define XB_SPIN_CAP (1u << 18)

__device__ __forceinline__ unsigned xb_ld(unsigned* p)              { return __hip_atomic_load(p, __ATOMIC_RELAXED, __HIP_MEMORY_SCOPE_AGENT); }
__device__ __forceinline__ unsigned xb_add(unsigned* p, unsigned v) { return __hip_atomic_fetch_add(p, v, __ATOMIC_RELAXED, __HIP_MEMORY_SCOPE_AGENT); }
__device__ __forceinline__ unsigned xb_xcc_id() { return (unsigned)__builtin_amdgcn_s_getreg((3 << 11) | 20) & 0xFu; }
#define XB_SPIN(cond, bar) do { unsigned _sp = 0; while (cond) { __builtin_amdgcn_s_sleep(1); \
    if ((++_sp & 255u) == 0u) { if (xb_ld(&(bar)[XB_TMO])) break; if (_sp > XB_SPIN_CAP) { atomicAdd(&(bar)[XB_TMO], 1u); break; } } } } while (0)

struct XcdBarrier {
    unsigned* bar; unsigned x;
    volatile LAS unsigned* st;
};

__device__ __forceinline__ XcdBarrier xcd_barrier_post(unsigned* bar, volatile LAS unsigned* st) {
    XcdBarrier b; b.bar = bar; b.x = xb_xcc_id(); b.st = st;
    if (threadIdx.x == 0) (void)xb_add(&bar[XB_XCNT(b.x)], 1u);
    return b;
}
__device__ __forceinline__ void xcd_barrier_complete(unsigned* bar, unsigned x, unsigned& nloc, unsigned& nx) {
    const unsigned G = gridDim.x * gridDim.y * gridDim.z;
    unsigned sum, cnt, mine, sp = 0u;
    for (;;) {
        sum = 0u; cnt = 0u; mine = 0u;
#pragma unroll
        for (unsigned j = 0; j < 16; ++j) { const unsigned c = xb_ld(&bar[XB_XCNT(j)]); sum += c; cnt += (c > 0u) ? 1u : 0u; mine = (j == x) ? c : mine; }
        if (sum == G) break;
        __builtin_amdgcn_s_sleep(1);
        if ((++sp & 255u) == 0u) { if (xb_ld(&bar[XB_TMO])) break; if (sp > XB_SPIN_CAP) { atomicAdd(&bar[XB_TMO], 1u); break; } }
    }
    nloc = mine > 0u ? mine : 1u; nx = cnt > 0u ? cnt : 1u;
}

__device__ __forceinline__ void xcd_barrier(const XcdBarrier& b) {
    asm volatile("s_waitcnt vmcnt(0)" ::: "memory");
    __syncthreads();
    if (threadIdx.x == 0) {
        unsigned* bar = b.bar;
        __builtin_amdgcn_s_waitcnt(0);
        unsigned nloc = b.st[0], nx = b.st[1];
        if (nloc == 0u) { xcd_barrier_complete(bar, b.x, nloc, nx); b.st[0] = nloc; b.st[1] = nx; }
        const unsigned old = xb_add(&bar[XB_XSUB(b.x)], 1u);
        const unsigned gen = old / nloc;
        if (old + 1u == (gen + 1u) * nloc) {
            __builtin_amdgcn_fence(__ATOMIC_RELEASE, "agent");
            asm volatile("s_waitcnt vmcnt(0)" ::: "memory");
            const unsigned og = xb_add(&bar[XB_TOP], 1u);
            const unsigned tg = og / nx;
            if (og + 1u == (tg + 1u) * nx) xb_add(&bar[XB_TOPGEN], 1u);
            else XB_SPIN(xb_ld(&bar[XB_TOPGEN]) == tg, bar);
            __builtin_amdgcn_fence(__ATOMIC_ACQUIRE, "agent");
            xb_add(&bar[XB_XGEN(b.x)], 1u);
            asm volatile("s_waitcnt vmcnt(0)" ::: "memory");
        } else {
            XB_SPIN(xb_ld(&bar[XB_XGEN(b.x)]) == gen, bar);
            __builtin_amdgcn_fence(__ATOMIC_ACQUIRE, "agent");
            asm volatile("s_waitcnt vmcnt(0)" ::: "memory");
        }
    }
    __syncthreads();
}

__device__ __forceinline__ float wave_sum(float v) {
#pragma unroll
    for (int o = 1; o < 64; o <<= 1) v += __shfl_xor(v, o);
    return v;
}
__device__ __forceinline__ float wave_max(float v) {
#pragma unroll
    for (int o = 1; o < 64; o <<= 1) v = fmaxf(v, __shfl_xor(v, o));
    return v;
}
__device__ __forceinline__ unsigned offb(unsigned row, unsigned ch) { return 256u * row + 16u * (ch ^ (((row & 3u) << 2) | ((row >> 2) & 3u))); }
typedef short v4i16_t __attribute__((ext_vector_type(4)));
__device__ __forceinline__ s16x4 tr_read(LAS unsigned char* p) { return __builtin_bit_cast(s16x4, __builtin_amdgcn_ds_read_tr16_b64_v4i16((LAS v4i16_t*)p)); }
__device__ __forceinline__ int crow(int reg, int h) { return (reg & 3) + 8 * (reg >> 2) + 4 * h; }
#define MFMA32(a, b, c) __builtin_amdgcn_mfma_f32_32x32x16_bf16((a), (b), (c), 0, 0, 0)
#define MFMA16(a, b, c) __builtin_amdgcn_mfma_f32_16x16x32_bf16((a), (b), (c), 0, 0, 0)

struct Args { const float* in[23]; float* out; unsigned char* ws; int ph_lo, ph_hi, li, pad; };

__device__ __forceinline__ void p0_transpose_item(const float* W, int K, int N, bf16_t* WT, int ldt, int koff, int mode, LAS float* scr, int item, int lane) {
    const int nblk = N / 32, kb = item / nblk, nb = item % nblk, k0 = 64 * kb, n0 = 32 * nb;
#pragma unroll 8
    for (int i = 0; i < 32; ++i) { const int kk = 2 * i + (lane >> 5); scr[kk * 33 + (lane & 31)] = W[(size_t)(k0 + kk) * N + n0 + (lane & 31)]; }
    LDS_WAIT(); asm volatile("" ::: "memory");
    int rbase = n0;
    if (mode == 1) { const int j = n0 >= FF ? n0 - FF : n0; rbase = 256 * (j >> 7) + (j & 127) + (n0 >= FF ? 128 : 0); }
    const int c = lane & 7;
#pragma unroll
    for (int j = 0; j < 4; ++j) { const int n = (lane >> 3) + 8 * j; const LAS float* s = scr + (8 * c) * 33 + n;
        u32x4 o; o.x = cvt_pk_bf16(s[0 * 33], s[1 * 33]); o.y = cvt_pk_bf16(s[2 * 33], s[3 * 33]); o.z = cvt_pk_bf16(s[4 * 33], s[5 * 33]); o.w = cvt_pk_bf16(s[6 * 33], s[7 * 33]);
        *(u32x4*)(WT + (size_t)(rbase + n) * ldt + koff + k0 + 8 * c) = o; }
    LDS_WAIT(); asm volatile("" ::: "memory");
}
struct KvCopy {
    const float *c0, *c1, *c2; float* out;
    static constexpr int NJ = 4, HR0 = DB * 128 * 2, HR1 = DB * 512 * 2, HR2 = DB * 2048 * 2, WC0 = HR0 / NJ, WC1 = HR1 / NJ, WC2 = HR2 / NJ, WCT = WC0 + WC1 + WC2;
    __device__ __forceinline__ unsigned locate(int wck, int lane, const char*& src, char*& dst) const {
        const float* c; size_t ob; int L;
        if (wck < WC0) { c = c0; ob = O_KV0S; L = 128; } else if (wck < WC0 + WC1) { wck -= WC0; c = c1; ob = O_KV1S; L = 512; } else { wck -= WC0 + WC1; c = c2; ob = O_KV2S; L = 2048; }
        const size_t off = (size_t)wck * (NJ * 1024) + lane * 16 + 2048;
        src = (const char*)c + 2048 + off; dst = (char*)(out + ob) + off;
        unsigned mask = 0u;
#pragma unroll
        for (int j = 0; j < NJ; ++j) { const int hr = wck * NJ + j; if (wck < WC2 && (((hr >> 1) & (L - 1)) != L - 1)) mask |= 1u << j; }
        return mask;
    }
    __device__ __forceinline__ void run(int first, int j0, int j1, int wave, int lane) const {
        for (int j = j0; j < j1; j += 2) {
            const char *sa, *sb; char *da, *db;
            const int wa = first + wave + 8 * j, wb = wa + 8; const bool hb = j + 1 < j1;
            const unsigned ma = __builtin_amdgcn_readfirstlane(locate(wa, lane, sa, da)), mb = hb ? __builtin_amdgcn_readfirstlane(locate(wb, lane, sb, db)) : 0u;
            f32x4 va[NJ], vb[NJ];
#pragma unroll
            for (int q = 0; q < NJ; ++q) { if (ma & (1u << q)) va[q] = __builtin_nontemporal_load((const f32x4*)(sa + (q * 1024 - 2048))); if (mb & (1u << q)) vb[q] = __builtin_nontemporal_load((const f32x4*)(sb + (q * 1024 - 2048))); }
#pragma unroll
            for (int q = 0; q < NJ; ++q) { if (ma & (1u << q)) __builtin_nontemporal_store(va[q], (f32x4*)(da + (q * 1024 - 2048))); if (mb & (1u << q)) __builtin_nontemporal_store(vb[q], (f32x4*)(db + (q * 1024 - 2048))); }
        }
    }
};
constexpr int KV_PER_PHASE = KvCopy::WCT / 4, KV_PER_CU = KV_PER_PHASE / 256, KV_PER_WAVE = KV_PER_CU / 8;
static_assert(KV_PER_PHASE * 4 == KvCopy::WCT && KV_PER_CU * 256 == KV_PER_PHASE && KV_PER_WAVE * 8 == KV_PER_CU, "KV copy split");
template <int NBF>
__device__ __forceinline__ void skinny_dot(f32x4 (&acc)[NBF], const bf16_t* ap, const bf16_t* bp0, const bf16_t* bp1, int nsteps) {
    for (int s = 0; s < nsteps; s += 8) {
        bf16x8 a[8], b0[8], b1[8];
#pragma unroll
        for (int j = 0; j < 8; ++j) { a[j] = *(const bf16x8*)(ap + (s + j) * 32); b0[j] = *(const bf16x8*)(bp0 + (s + j) * 32); if (NBF > 1) b1[j] = *(const bf16x8*)(bp1 + (s + j) * 32); }
#pragma unroll
        for (int j = 0; j < 8; ++j) { acc[0] = MFMA16(b0[j], a[j], acc[0]); if (NBF > 1) acc[1] = MFMA16(b1[j], a[j], acc[1]); }
    }
}

__device__ __forceinline__ void norm_mod_rows(const float* X, const float* XSmp, const float* gain, const float* mod, int idx, bf16_t* XN, int gw, int NGW, int lane) {
    for (int blk = gw; blk < MP / 32 + DB; blk += NGW) {
        const bool smp = blk >= MP / 32;
        const int b = smp ? NB + (blk - MP / 32) : (blk >> 7);
        const float* mp = mod + (size_t)b * NADA + (3 * idx) * D;
        f32x4 ca[4], cs[4];
#pragma unroll
        for (int j = 0; j < 4; ++j) { const int col = 4 * lane + 256 * j; const f32x4 gg = *(const f32x4*)(gain + col), sc = *(const f32x4*)(mp + D + col); ca[j] = gg * (sc + 1.0f); cs[j] = *(const f32x4*)(mp + col); }
        if (smp) {
            const float* src = XSmp + (size_t)(blk - MP / 32) * D; bf16_t* dst = XN + (size_t)(MP + blk - MP / 32) * D;
            f32x4 v[4]; float ss = 0.f;
#pragma unroll
            for (int j = 0; j < 4; ++j) { v[j] = *(const f32x4*)(src + 4 * lane + 256 * j); ss += (v[j][0] * v[j][0] + v[j][1] * v[j][1]) + (v[j][2] * v[j][2] + v[j][3] * v[j][3]); }
            const float r = __builtin_amdgcn_rsqf(wave_sum(ss) * (1.0f / D) + EPS);
#pragma unroll
            for (int j = 0; j < 4; ++j) { const f32x4 o = v[j] * r * ca[j] + cs[j]; u32x2 w; w.x = cvt_pk_bf16(o[0], o[1]); w.y = cvt_pk_bf16(o[2], o[3]); *(u32x2*)(dst + 4 * lane + 256 * j) = w; }
        } else {
            const float* src = X + (size_t)blk * 32 * D; bf16_t* dst = XN + (size_t)blk * 32 * D;
            for (int rr = 0; rr < 32; rr += 4) {
                f32x4 v[4][4]; float ss[4];
#pragma unroll
                for (int q = 0; q < 4; ++q)
#pragma unroll
                    for (int j = 0; j < 4; ++j) v[q][j] = *(const f32x4*)(src + (size_t)(rr + q) * D + 4 * lane + 256 * j);
#pragma unroll
                for (int q = 0; q < 4; ++q) { ss[q] = 0.f;
#pragma unroll
                    for (int j = 0; j < 4; ++j) ss[q] += (v[q][j][0] * v[q][j][0] + v[q][j][1] * v[q][j][1]) + (v[q][j][2] * v[q][j][2] + v[q][j][3] * v[q][j][3]); }
#pragma unroll
                for (int q = 0; q < 4; ++q) { const float r = __builtin_amdgcn_rsqf(wave_sum(ss[q]) * (1.0f / D) + EPS);
#pragma unroll
                    for (int j = 0; j < 4; ++j) { const f32x4 o = v[q][j] * r * ca[j] + cs[j]; u32x2 w; w.x = cvt_pk_bf16(o[0], o[1]); w.y = cvt_pk_bf16(o[2], o[3]); *(u32x2*)(dst + (size_t)(rr + q) * D + 4 * lane + 256 * j) = w; } }
            }
        }
    }
}
__device__ __forceinline__ void final_norm_rows(float* Y, const float* XSmp, float* YS, const float* gain, int gw, int NGW, int lane) {
    f32x4 cg[4];
#pragma unroll
    for (int j = 0; j < 4; ++j) cg[j] = *(const f32x4*)(gain + 4 * lane + 256 * j);
    for (int blk = gw; blk < MP / 32 + DB / 2; blk += NGW) {
        const bool smp = blk >= MP / 32;
        const int nrows = smp ? 2 : 32;
        const float* src = smp ? XSmp + (size_t)(blk - MP / 32) * 2 * D : Y + (size_t)blk * 32 * D;
        float* dst = smp ? YS + (size_t)(blk - MP / 32) * 2 * D : Y + (size_t)blk * 32 * D;
        for (int rr = 0; rr < nrows; rr += 2) {
            f32x4 v[2][4]; float ss[2];
#pragma unroll
            for (int q = 0; q < 2; ++q) { ss[q] = 0.f;
#pragma unroll
                for (int j = 0; j < 4; ++j) { v[q][j] = *(const f32x4*)(src + (size_t)(rr + q) * D + 4 * lane + 256 * j); ss[q] += (v[q][j][0] * v[q][j][0] + v[q][j][1] * v[q][j][1]) + (v[q][j][2] * v[q][j][2] + v[q][j][3] * v[q][j][3]); } }
#pragma unroll
            for (int q = 0; q < 2; ++q) { const float r = __builtin_amdgcn_rsqf(wave_sum(ss[q]) * (1.0f / D) + EPS);
#pragma unroll
                for (int j = 0; j < 4; ++j) *(f32x4*)(dst + (size_t)(rr + q) * D + 4 * lane + 256 * j) = v[q][j] * r * cg[j]; }
        }
    }
}

struct AttnUnit { int hp, g, b, dsh, r, n, head0; size_t tok0; };
__device__ __forceinline__ AttnUnit attn_decode(int unit) {
    AttnUnit a; a.hp = unit & 1; const int rn = (unit >> 1) & 31, gb = unit >> 6; a.g = gb % 3; a.b = gb / 3;
    a.dsh = 2 * a.g; const int dil = 1 << a.dsh; a.r = rn & (dil - 1); a.n = rn >> a.dsh; a.tok0 = (size_t)a.b * SEQ + a.r; a.head0 = 4 * a.g + 2 * a.hp; return a;
}
__device__ __forceinline__ void attn_load(const bf16_t* QKV, int unit, int tid, u32x4 (&kreg)[8], u32x4 (&vreg)[8]) {
    const AttnUnit a = attn_decode(unit);
    const int jj_lo = (a.n == 0) ? 128 : 0;
#pragma unroll
    for (int it = 0; it < 8; ++it) {
        const int cid = it * 512 + tid, row = cid >> 4, ch = cid & 15;
        if (row >= jj_lo) {
            const size_t tok = a.tok0 + ((size_t)((a.n - 1) * 128 + row) << a.dsh);
            const bf16_t* src = QKV + tok * 2304 + a.head0 * 64 + ch * 8;
            kreg[it] = *(const u32x4*)(src + DATT); vreg[it] = *(const u32x4*)(src + 2 * DATT);
        }
    }
}
__device__ __forceinline__ void attn_load_q(const bf16_t* QKV, int unit, int wave, int lane, bf16x8 (&qf)[4]) {
    const AttnUnit a = attn_decode(unit);
    const int hsel = wave >> 2, qsub = wave & 3, ql = lane & 31, h = lane >> 5;
    const size_t tokq = a.tok0 + ((size_t)(a.n * 128 + 32 * qsub + ql) << a.dsh);
    const bf16_t* qp = QKV + tokq * 2304 + (a.head0 + hsel) * 64 + 8 * h;
#pragma unroll
    for (int dc = 0; dc < 4; ++dc) qf[dc] = *(const bf16x8*)(qp + 16 * dc);
}
__device__ __forceinline__ void attn_write(LAS unsigned char* lds, int unit, int tid, const u32x4 (&kreg)[8], const u32x4 (&vreg)[8]) {
    const AttnUnit a = attn_decode(unit);
    const int jj_lo = (a.n == 0) ? 128 : 0;
    LAS unsigned char* Kimg = lds; LAS unsigned char* Vimg = lds + 65536;
#pragma unroll
    for (int it = 0; it < 8; ++it) {
        const int cid = it * 512 + tid, row = cid >> 4, ch = cid & 15;
        if (row >= jj_lo) { *(LAS u32x4*)(Kimg + offb(row, ch)) = kreg[it]; *(LAS u32x4*)(Vimg + offb(row, ch)) = vreg[it]; }
    }
}
__device__ __forceinline__ void attn_compute(LAS unsigned char* lds, bf16_t* AG, float* LSE, int unit, int wave, int lane, const bf16x8 (&qf)[4]) {
    const AttnUnit a = attn_decode(unit);
    const int n = a.n;
    LAS unsigned char* Kimg = lds; LAS unsigned char* Vimg = lds + 65536;
    const int hsel = wave >> 2, qsub = wave & 3, ql = lane & 31, h = lane >> 5;
    const int q4 = (lane & 15) >> 2, p4 = lane & 3, blk = (lane >> 4) & 1;
    const size_t tokq = a.tok0 + ((size_t)(n * 128 + 32 * qsub + ql) << a.dsh);
    const float cs = 0.125f * 1.44269504089f;
    f32x16 o0, o1;
#pragma unroll
    for (int i = 0; i < 16; ++i) { o0[i] = 0.f; o1[i] = 0.f; }
    float m = -INFINITY, l = 0.f;
#pragma unroll
    for (int tt = 0; tt < 5; ++tt) {
        const int jt = qsub + tt;
        if (!(n == 0 && jt < 4)) {
            f32x16 s;
#pragma unroll
            for (int i = 0; i < 16; ++i) s[i] = 0.f;
#pragma unroll
            for (int dc = 0; dc < 4; ++dc) { const bf16x8 kf = *(const LAS bf16x8*)(Kimg + offb(32 * jt + ql, hsel * 8 + 2 * dc + h)); s = MFMA32(kf, qf[dc], s); }
            float tm = -INFINITY;
#pragma unroll
            for (int i = 0; i < 16; ++i) { const int kr = crow(i, h); bool ok = true; if (tt == 0) ok = (kr >= ql); if (tt == 4) ok = (kr <= ql); s[i] = ok ? s[i] : -INFINITY; tm = fmaxf(tm, s[i]); }
            tm = fmaxf(tm, __shfl_xor(tm, 32));
            const float mn = fmaxf(m, tm), alpha = __builtin_amdgcn_exp2f((m - mn) * cs), mc = mn * cs;
            m = mn;
            float ps = 0.f;
#pragma unroll
            for (int i = 0; i < 16; ++i) { const float p = __builtin_amdgcn_exp2f(s[i] * cs - mc); s[i] = p; ps += p; }
            l = l * alpha + ps;
#pragma unroll
            for (int i = 0; i < 16; ++i) { o0[i] *= alpha; o1[i] *= alpha; }
#pragma unroll
            for (int ks = 0; ks < 2; ++ks) {
                u32x4 pw;
                pw.x = cvt_pk_bf16(s[8 * ks + 0], s[8 * ks + 1]); pw.y = cvt_pk_bf16(s[8 * ks + 2], s[8 * ks + 3]);
                pw.z = cvt_pk_bf16(s[8 * ks + 4], s[8 * ks + 5]); pw.w = cvt_pk_bf16(s[8 * ks + 6], s[8 * ks + 7]);
                const bf16x8 pf = __builtin_bit_cast(bf16x8, pw);
                const int row0 = 32 * jt + 16 * ks + 4 * h + q4;
#pragma unroll
                for (int c = 0; c < 2; ++c) {
                    const int chv = hsel * 8 + 4 * c + 2 * blk + (p4 >> 1);
                    const s16x4 lo = tr_read(Vimg + offb(row0, chv) + 8 * (p4 & 1)), hi = tr_read(Vimg + offb(row0 + 8, chv) + 8 * (p4 & 1));
                    const bf16x8 vf = __builtin_shufflevector(lo, hi, 0, 1, 2, 3, 4, 5, 6, 7);
                    if (c == 0) o0 = MFMA32(vf, pf, o0); else o1 = MFMA32(vf, pf, o1);
                }
            }
        }
    }
    l += __shfl_xor(l, 32);
    const float inv = 1.0f / l;
    bf16_t* op = AG + tokq * KAG + (a.head0 + hsel) * 64 + 4 * h;
#pragma unroll
    for (int gq = 0; gq < 4; ++gq) {
        u32x2 w0, w1;
        w0.x = cvt_pk_bf16(o0[4 * gq] * inv, o0[4 * gq + 1] * inv); w0.y = cvt_pk_bf16(o0[4 * gq + 2] * inv, o0[4 * gq + 3] * inv);
        w1.x = cvt_pk_bf16(o1[4 * gq] * inv, o1[4 * gq + 1] * inv); w1.y = cvt_pk_bf16(o1[4 * gq + 2] * inv, o1[4 * gq + 3] * inv);
        *(u32x2*)(op + 8 * gq) = w0; *(u32x2*)(op + 32 + 8 * gq) = w1;
    }
    if (h == 0) LSE[tokq * 12 + a.head0 + hsel] = m * 0.125f + __logf(l);
}
__device__ __forceinline__ void attn_prompt_phase(LAS unsigned char* lds, const bf16_t* QKV, bf16_t* AG, float* LSE, int vcu, int G, int tid, int wave, int lane) {
    constexpr int NU = NB * 3 * 32 * 2;
    u32x4 kreg[8], vreg[8]; bf16x8 qn[4], qc[4];
    int u = vcu;
    if (u < NU) { attn_load(QKV, u, tid, kreg, vreg); attn_load_q(QKV, u, wave, lane, qn); }
    while (u < NU) {
        attn_write(lds, u, tid, kreg, vreg);
#pragma unroll
        for (int dc = 0; dc < 4; ++dc) qc[dc] = qn[dc];
        __syncthreads();
        const int un = u + G;
        if (un < NU) { attn_load(QKV, un, tid, kreg, vreg); attn_load_q(QKV, un, wave, lane, qn); }
        attn_compute(lds, AG, LSE, u, wave, lane, qc);
        __syncthreads();
        u = un;
    }
}

__device__ __forceinline__ void gmlp_phase(LAS unsigned char* lds, const bf16_t* VB, const bf16_t* U, const bf16_t* WSP, const float* bsp, const float* lng, const float* lnb, bf16_t* AG, float* out,
                                           int vcu, int G, int wave, int lane) {
    const int grp = wave >> 1, ql = lane & 31, h = lane >> 5, q4 = (lane & 15) >> 2, p4 = lane & 3, blk = (lane >> 4) & 1;
    bf16x8 bw[20];
    {
        const bf16_t* wg = WSP + (size_t)grp * 128 * 128 + 8 * h;
        int idx = 0;
#pragma unroll
        for (int s = 0; s < 8; ++s)
#pragma unroll
            for (int it = s >> 1; it < 4; ++it) { bw[idx] = *(const bf16x8*)(wg + (size_t)(32 * it + ql) * 128 + 16 * s); ++idx; }
    }
    const f32x4 g0 = *(const f32x4*)(lng + 8 * lane), g1 = *(const f32x4*)(lng + 8 * lane + 4), b0 = *(const f32x4*)(lnb + 8 * lane), b1 = *(const f32x4*)(lnb + 8 * lane + 4);
    for (int unit = vcu; unit < NB * 32; unit += G) {
        const int b = unit >> 5, c = unit & 31;
        const size_t tokb = (size_t)b * SEQ + c * 128;
        {
            LAS unsigned char* img = lds + (lane >> 4) * 32768;
            u32x4 xr[16];
#pragma unroll
            for (int jr = 0; jr < 16; ++jr) xr[jr] = *(const u32x4*)(VB + (tokb + 16 * wave + jr) * DG + 8 * lane);
#pragma unroll
            for (int jr = 0; jr < 16; ++jr) {
                const int j = 16 * wave + jr; const u32x4 x = xr[jr];
                f32x4 v0, v1; v0[0] = bflo(x.x); v0[1] = bfhi(x.x); v0[2] = bflo(x.y); v0[3] = bfhi(x.y); v1[0] = bflo(x.z); v1[1] = bfhi(x.z); v1[2] = bflo(x.w); v1[3] = bfhi(x.w);
                const float mean = wave_sum((v0[0] + v0[1]) + (v0[2] + v0[3]) + (v1[0] + v1[1]) + (v1[2] + v1[3])) * (1.0f / DG);
                v0 = v0 - mean; v1 = v1 - mean;
                const float var = wave_sum((v0[0] * v0[0] + v0[1] * v0[1]) + (v0[2] * v0[2] + v0[3] * v0[3]) + (v1[0] * v1[0] + v1[1] * v1[1]) + (v1[2] * v1[2] + v1[3] * v1[3])) * (1.0f / DG);
                const float rstd = __builtin_amdgcn_rsqf(var + EPS);
                v0 = v0 * rstd * g0 + b0; v1 = v1 * rstd * g1 + b1;
                if (c == 31) { float* vo = out + O_VRP + ((size_t)b * 128 + j) * DG + 8 * lane; *(f32x4*)vo = v0; *(f32x4*)(vo + 4) = v1; }
                u32x4 w; w.x = cvt_pk_bf16(v0[0], v0[1]); w.y = cvt_pk_bf16(v0[2], v0[3]); w.z = cvt_pk_bf16(v1[0], v1[1]); w.w = cvt_pk_bf16(v1[2], v1[3]);
                *(LAS u32x4*)(img + offb(j, lane & 15)) = w;
            }
        }
        __syncthreads();
        LAS unsigned char* img = lds + grp * 32768;
#pragma unroll 1
        for (int cc = 0; cc < 2; ++cc) {
            const int c32 = (wave & 1) * 2 + cc;
            f32x16 acc[4];
#pragma unroll
            for (int it = 0; it < 4; ++it)
#pragma unroll
                for (int i = 0; i < 16; ++i) acc[it][i] = 0.f;
            const int chv = 4 * c32 + 2 * blk + (p4 >> 1);
            int idx = 0;
#pragma unroll
            for (int s = 0; s < 8; ++s) {
                const int row0 = 16 * s + 8 * h + q4;
                const s16x4 lo = tr_read(img + offb(row0, chv) + 8 * (p4 & 1)), hi = tr_read(img + offb(row0 + 4, chv) + 8 * (p4 & 1));
                const bf16x8 af = __builtin_shufflevector(lo, hi, 0, 1, 2, 3, 4, 5, 6, 7);
#pragma unroll
                for (int it = s >> 1; it < 4; ++it) { acc[it] = MFMA32(af, bw[idx], acc[it]); ++idx; }
            }
#pragma unroll
            for (int it = 0; it < 4; ++it) {
                const int i = 32 * it + ql; const float bias = bsp[grp * 128 + i];
                const size_t tok = tokb + i;
                const bf16_t* up = U + tok * DG + grp * 128 + 32 * c32 + 4 * h;
                bf16_t* gp = AG + tok * KAG + DATT + grp * 128 + 32 * c32 + 4 * h;
#pragma unroll
                for (int gq = 0; gq < 4; ++gq) { const u32x2 uu = *(const u32x2*)(up + 8 * gq);
                    u32x2 w; w.x = cvt_pk_bf16(bflo(uu.x) * (acc[it][4 * gq] + bias), bfhi(uu.x) * (acc[it][4 * gq + 1] + bias)); w.y = cvt_pk_bf16(bflo(uu.y) * (acc[it][4 * gq + 2] + bias), bfhi(uu.y) * (acc[it][4 * gq + 3] + bias));
                    *(u32x2*)(gp + 8 * gq) = w; }
            }
        }
        __syncthreads();
    }
}

__device__ __forceinline__ void sample_unit(LAS unsigned char* lds, const float* PROJS, const float* c0, const float* c1, const float* c2, const float* wsp, const float* bsp, const float* lng, const float* lnb,
                                            bf16_t* AG, float* out, int b, int tid, int wave, int lane) {
    LAS float* qs = (LAS float*)(lds + SMP_OFF) + wave * 64;
    LAS float* ps = (LAS float*)(lds + SMP_OFF + 2048) + wave * 128;
    LAS float* osh = (LAS float*)(lds + SMP_OFF + 6144);
    LAS float* lsv = (LAS float*)(lds + SMP_OFF + 9216);
    const float* pr = PROJS + (size_t)b * DIN;
#pragma unroll 1
    for (int head = wave; head < 12; head += 8) {
        const int g = head >> 2, hh = head & 3, dsh = 2 * g, L = 128 << dsh;
        const float* cg = (g == 0 ? c0 : (g == 1 ? c1 : c2)) + (size_t)b * L * 512;
        const float qv = pr[head * 64 + lane];
        qs[lane] = qv;
        LDS_WAIT(); asm volatile("" ::: "memory");
        float sc[2];
#pragma unroll
        for (int kk = 0; kk < 2; ++kk) {
            const float* kp = cg + ((size_t)(lane + 64 * kk) << dsh) * 512 + hh * 64;
            float d = 0.f;
#pragma unroll
            for (int j = 0; j < 16; ++j) { const f32x4 kv = *(const f32x4*)(kp + 4 * j); const f32x4 q4v = *(const LAS f32x4*)(qs + 4 * j); d += (kv[0] * q4v[0] + kv[1] * q4v[1]) + (kv[2] * q4v[2] + kv[3] * q4v[3]); }
            sc[kk] = d * 0.125f;
        }
        const float snew = wave_sum(qv * pr[DATT + head * 64 + lane]) * 0.125f;
        const float mx = wave_max(fmaxf(fmaxf(sc[0], sc[1]), snew));
        const float p0 = __expf(sc[0] - mx), p1 = __expf(sc[1] - mx), pn = __expf(snew - mx);
        const float l = wave_sum(p0 + p1) + pn;
        ps[lane] = p0; ps[lane + 64] = p1;
        LDS_WAIT(); asm volatile("" ::: "memory");
        {
            const int ks = lane >> 4, dq = lane & 15;
            const float* vp = cg + 256 + hh * 64 + 4 * dq;
            f32x4 o4 = (f32x4){0.f, 0.f, 0.f, 0.f};
            if (ks == 0) o4 = *(const f32x4*)(pr + 2 * DATT + head * 64 + 4 * dq) * pn;
#pragma unroll 8
            for (int it = 0; it < 32; ++it) { const int m = 4 * it + ks; o4 += *(const f32x4*)(vp + ((size_t)m << dsh) * 512) * ps[m]; }
#pragma unroll
            for (int e = 0; e < 4; ++e) { float t = o4[e]; t += __shfl_xor(t, 16); t += __shfl_xor(t, 32); o4[e] = t; }
            if (ks == 0) *(LAS f32x4*)(osh + head * 64 + 4 * dq) = o4 * (1.0f / l);
        }
        if (lane == 0) lsv[head] = mx + __logf(l);
        LDS_WAIT(); asm volatile("" ::: "memory");
    }
    __syncthreads();
    for (int t = tid; t < DATT; t += NWAVES * 64) {
        const int head = t >> 6, hh = head & 3, g = head >> 2;
        const float l0 = lsv[hh], l1 = lsv[4 + hh], l2 = lsv[8 + hh], m = fmaxf(l0, fmaxf(l1, l2));
        const float e0 = __expf(l0 - m), e1 = __expf(l1 - m), e2 = __expf(l2 - m);
        const float w = (g == 0 ? e0 : (g == 1 ? e1 : e2)) / (e0 + e1 + e2);
        AG[(size_t)(MP + b) * KAG + t] = (bf16_t)(cvt_pk_bf16(osh[t] * w, 0.f) & 0xffffu);
    }
    if (wave == 4) {
        const int grp = lane >> 4;
        f32x4 v0 = *(const f32x4*)(pr + 2816 + 8 * lane), v1 = *(const f32x4*)(pr + 2816 + 8 * lane + 4);
        const float mean = wave_sum((v0[0] + v0[1]) + (v0[2] + v0[3]) + (v1[0] + v1[1]) + (v1[2] + v1[3])) * (1.0f / DG);
        v0 = v0 - mean; v1 = v1 - mean;
        const float var = wave_sum((v0[0] * v0[0] + v0[1] * v0[1]) + (v0[2] * v0[2] + v0[3] * v0[3]) + (v1[0] * v1[0] + v1[1] * v1[1]) + (v1[2] * v1[2] + v1[3] * v1[3])) * (1.0f / DG);
        const float rstd = __builtin_amdgcn_rsqf(var + EPS);
        v0 = v0 * rstd * *(const f32x4*)(lng + 8 * lane) + *(const f32x4*)(lnb + 8 * lane); v1 = v1 * rstd * *(const f32x4*)(lng + 8 * lane + 4) + *(const f32x4*)(lnb + 8 * lane + 4);
        float* vo = out + O_VRS + (size_t)b * DG + 8 * lane; *(f32x4*)vo = v0; *(f32x4*)(vo + 4) = v1;
        const float w00 = wsp[(size_t)grp * 128 * 128], b00 = bsp[grp * 128];
        const f32x4 u0 = *(const f32x4*)(pr + 2304 + 8 * lane), u1 = *(const f32x4*)(pr + 2304 + 8 * lane + 4);
        const f32x4 m0 = u0 * (v0 * w00 + b00), m1 = u1 * (v1 * w00 + b00);
        u32x4 w; w.x = cvt_pk_bf16(m0[0], m0[1]); w.y = cvt_pk_bf16(m0[2], m0[3]); w.z = cvt_pk_bf16(m1[0], m1[1]); w.w = cvt_pk_bf16(m1[2], m1[3]);
        *(u32x4*)(AG + (size_t)(MP + b) * KAG + DATT + 8 * lane) = w;
    }
    __syncthreads();
}


#define INP(k) (args.in[k])
#define WSB(off) ((bf16_t*)(ws + (off)))
#define WSF(off) ((float*)(ws + (off)))
#define x_prompt INP(0)
#define x_sample INP(1)
#define c_prompt INP(2)
#define c_sample INP(3)
#define cache0 INP(4)
#define cache1 INP(5)
#define cache2 INP(6)
#define ada_w INP(7)
#define ada_b INP(8)
#define norm_g INP(9)
#define ffn1_up INP(10)
#define ffn1_down INP(11)
#define w_in INP(12)
#define w_ba INP(13)
#define w_bb INP(14)
#define w_out INP(15)
#define v_ln_g INP(16)
#define v_ln_b INP(17)
#define w_sp INP(18)
#define b_sp INP(19)
#define ffn2_up INP(20)
#define ffn2_down INP(21)
#define final_g INP(22)
#define W1U WSB(WS_W1U)
#define W1D WSB(WS_W1D)
#define WIN WSB(WS_WIN)
#define WAB WSB(WS_WAB)
#define WO WSB(WS_WO)
#define W2U WSB(WS_W2U)
#define W2D WSB(WS_W2D)
#define ADAW WSB(WS_ADAW)
#define AADA WSB(WS_AADA)
#define MOD WSF(WS_MOD)
#define WSP WSB(WS_WSP)
#define XS WSF(WS_XS)
#define PROJS WSF(WS_PROJS)
#define LSE WSF(WS_LSE)
#define XN WSB(WS_XN)
#define HB WSB(WS_H)
#define QKV WSB(WS_QKV)
#define UB WSB(WS_U)
#define VBB WSB(WS_VB)
#define SA WSB(WS_SA)
#define SB WSB(WS_SB)
#define AG WSB(WS_AG)
#define MG WSB(WS_MG)
#define YP (out + O_YP)
#define SH1 WSB(WS_SH1)
#define SH2 WSB(WS_SH2)
#define BIAS1 WSF(WS_BIAS1)
#define BIAS2 WSF(WS_BIAS2)
#define RSS1 WSF(WS_RSS1)
#define RSS2 WSF(WS_RSS2)
#define LANE_VARS() int tidv = threadIdx.x; asm volatile("" : "+v"(tidv)); const int lane = tidv & 63, fr = lane & 15, fq = lane >> 4; const size_t gt = (size_t)vcu * (NWAVES * 64) + tidv; (void)lane; (void)fr; (void)fq; (void)gt
__global__ void __launch_bounds__(NWAVES * 64, 2) fwd_kernel(Args args) {
    extern __shared__ __attribute__((aligned(16))) unsigned char lds_raw[];
    LAS unsigned char* lds = (LAS unsigned char*)lds_raw;
    const int tid = threadIdx.x, wave = __builtin_amdgcn_readfirstlane(tid >> 6);
    const int G = gridDim.x, bx = blockIdx.x;
    const int vcu = (G % 8 == 0) ? (bx % 8) * (G / 8) + bx / 8 : bx;
    const int gw = vcu * NWAVES + wave, NGW = G * NWAVES;
    const size_t NT = (size_t)G * (NWAVES * 64);
    unsigned char* ws = args.ws;
    unsigned* ctl = (unsigned*)(ws + WS_CTL);
    for (int u = tid; u < (LDS_BYTES - LDSCTL_OFF) / 4; u += NWAVES * 64) ((LAS unsigned*)(lds + LDSCTL_OFF))[u] = 0u;
    __syncthreads();
    volatile LAS unsigned* MISC = (volatile LAS unsigned*)(lds + MISC_OFF);
    XcdBarrier bar; bar.bar = ctl + CW_BAR; bar.x = 0; bar.st = nullptr;
    bar = xcd_barrier_post(ctl + CW_BAR + args.li * XCD_BAR_WORDS, MISC + 8);
#define GRID_BAR() xcd_barrier(bar)
    const int lo = args.ph_lo, hi = args.ph_hi;
#define IN(k) (lo <= (k) && (k) < hi)
#define BOTH(k) (IN(k) && IN((k) + 1))
    float* const out = args.out;
#define KV_BEFORE(KVQ) do { const KvCopy kc{cache0, cache1, cache2, out}; \
        if (G == 256) kc.run((KVQ) * KV_PER_PHASE + vcu * KV_PER_CU, 0, (KV_PER_WAVE * (vcu & 3)) / 3, wave, lane); \
        else for (int w0 = (KVQ) * KV_PER_PHASE + vcu * 8; w0 < ((KVQ) + 1) * KV_PER_PHASE; w0 += G * 8) kc.run(w0, 0, 1, wave, lane); } while (0)
#define KV_AFTER(KVQ) do { const KvCopy kc{cache0, cache1, cache2, out}; \
        if (G == 256) kc.run((KVQ) * KV_PER_PHASE + vcu * KV_PER_CU, (KV_PER_WAVE * (vcu & 3)) / 3, KV_PER_WAVE, wave, lane); } while (0)
#if SIMPLE_GEMM
#define RUN_GEMM(EPI, g, S, E) pg8::gemm_simple<EPI, pg8::StaticOrder>(g, S, E)
#else
#define RUN_GEMM(EPI, g, S, E) pg8::gemm_phase<EPI, pg8::StaticOrder, true, true>(lds + RING_OFF, g, S, E)
#endif

    if (IN(0)) {
        LANE_VARS();
        LAS float* scr = (LAS float*)(lds + RING_OFF + wave * 16384);
        constexpr int I_ADA = (D / 64) * (NADA / 32), I_UP = (D / 64) * (2 * FF / 32), I_DN = (FF / 64) * (D / 32), I_IN = (D / 64) * (DIN / 32), I_A = (DATT / 64) * (D / 32), I_B = (DG / 64) * (D / 32), I_O = (D / 64) * (D / 32);
        constexpr int NITEMS = I_ADA + 2 * I_UP + 2 * I_DN + I_IN + I_A + I_B + I_O;
        for (int it = gw; it < NITEMS; it += NGW) {
            int r = it;
            if (r < I_ADA) { p0_transpose_item(ada_w, D, NADA, ADAW, D, 0, 0, scr, r, lane); continue; } r -= I_ADA;
            if (r < I_UP) { p0_transpose_item(ffn1_up, D, 2 * FF, W1U, D, 0, 1, scr, r, lane); continue; } r -= I_UP;
            if (r < I_DN) { p0_transpose_item(ffn1_down, FF, D, W1D, FF, 0, 0, scr, r, lane); continue; } r -= I_DN;
            if (r < I_IN) { p0_transpose_item(w_in, D, DIN, WIN, D, 0, 0, scr, r, lane); continue; } r -= I_IN;
            if (r < I_A) { p0_transpose_item(w_ba, DATT, D, WAB, KAG, 0, 0, scr, r, lane); continue; } r -= I_A;
            if (r < I_B) { p0_transpose_item(w_bb, DG, D, WAB, KAG, DATT, 0, scr, r, lane); continue; } r -= I_B;
            if (r < I_O) { p0_transpose_item(w_out, D, D, WO, D, 0, 0, scr, r, lane); continue; } r -= I_O;
            if (r < I_UP) { p0_transpose_item(ffn2_up, D, 2 * FF, W2U, D, 0, 1, scr, r, lane); continue; } r -= I_UP;
            p0_transpose_item(ffn2_down, FF, D, W2D, FF, 0, 0, scr, r, lane);
        }
        for (size_t i = gt; i < (size_t)NMOD * D / 4; i += NT) {
            const f32x4 c = (i < (size_t)NB * D / 4) ? ((const f32x4*)c_prompt)[i] : ((const f32x4*)c_sample)[i - (size_t)NB * D / 4];
            u32x2 w; w.x = cvt_pk_bf16(siluf_(c[0]), siluf_(c[1])); w.y = cvt_pk_bf16(siluf_(c[2]), siluf_(c[3]));
            ((u32x2*)AADA)[i] = w;
        }
        for (size_t i = gt; i < 3 * D / 4; i += NT) ((f32x4*)WSF(WS_NG))[i] = ((const f32x4*)norm_g)[i];
        for (size_t i = gt; i < (size_t)4 * 128 * 128 / 4; i += NT) {
            const int j0 = (int)(i & 31) * 4, rr = (int)(i >> 5) & 127;
            const f32x4 v = ((const f32x4*)w_sp)[i];
            u32x2 w; w.x = cvt_pk_bf16(j0 <= rr ? v[0] : 0.f, j0 + 1 <= rr ? v[1] : 0.f); w.y = cvt_pk_bf16(j0 + 2 <= rr ? v[2] : 0.f, j0 + 3 <= rr ? v[3] : 0.f);
            ((u32x2*)WSP)[i] = w;
        }
        if (BOTH(0)) GRID_BAR();
    }

    if (IN(1)) {
        LANE_VARS();
        for (int it = vcu; it < NADA / 16; it += G)
            for (int rb = wave; rb < NMOD / 16; rb += NWAVES) {
                f32x4 acc[1]; acc[0] = (f32x4){0.f, 0.f, 0.f, 0.f};
                const bf16_t* bp = ADAW + (size_t)(16 * it + fr) * D + 8 * fq;
                skinny_dot<1>(acc, AADA + (size_t)(16 * rb + fr) * D + 8 * fq, bp, bp, D / 32);
                const int col = 16 * it + 4 * fq;
                const f32x4 mv = acc[0] + *(const f32x4*)(ada_b + col); *(f32x4*)(MOD + (size_t)(16 * rb + fr) * NADA + col) = mv;
                if ((col >= 3 * D && col < 4 * D) || (col >= 6 * D && col < 7 * D)) {
                    u32x2 w; w.x = cvt_pk_bf16(mv[0], mv[1]); w.y = cvt_pk_bf16(mv[2], mv[3]);
                    *(u32x2*)((col < 4 * D ? SH1 : SH2) + (size_t)(16 * rb + fr) * D + (col & (D - 1))) = w; }
            }
        if (BOTH(1)) GRID_BAR();
    }

    if (IN(2)) {
        LANE_VARS();
        if (wave < 4) norm_mod_rows(x_prompt, x_sample, norm_g, MOD, 0, XN, vcu * 4 + wave, G * 4, lane);
        else {
            constexpr int NCB = (DIN + 2 * FF) / 16, NRB = NMOD / 16;
            for (int wi = vcu * 4 + (wave - 4); wi < NCB * NRB; wi += G * 4) {
                const int it = wi / NRB, rb = wi - it * NRB;
                const bool two = it >= DIN / 16; const int nb = two ? it - DIN / 16 : it, ncol = two ? 2 * FF : DIN;
                const bf16_t* wt = two ? W2U : WIN; const bf16_t* sh = two ? SH2 : SH1; float* bo = two ? BIAS2 : BIAS1;
                f32x4 acc[1]; acc[0] = (f32x4){0.f, 0.f, 0.f, 0.f};
                const bf16_t* bp = wt + (size_t)(16 * nb + fr) * D + 8 * fq;
                skinny_dot<1>(acc, sh + (size_t)(16 * rb + fr) * D + 8 * fq, bp, bp, D / 32);
                *(f32x4*)(bo + (size_t)(16 * rb + fr) * ncol + 16 * nb + 4 * fq) = acc[0];
            }
        }
        if (BOTH(2)) GRID_BAR();
    }

#define FFN_UP_PHASE(WU, DEFN) do { \
        for (int it = vcu; it < FF / 16; it += G) {                                      \
            const int j0 = 16 * it, ra0 = 256 * (j0 >> 7) + (j0 & 127), ra = ra0 + fr, srow = 16 * wave + fr; \
            f32x4 acc[2]; acc[0] = (f32x4){0.f, 0.f, 0.f, 0.f}; acc[1] = acc[0]; \
            const size_t row = (size_t)MP + srow; \
            skinny_dot<2>(acc, XN + row * D + 8 * fq, (WU) + (size_t)ra * D + 8 * fq, (WU) + (size_t)(ra + 128) * D + 8 * fq, D / 32); \
            if (DEFN) { const float r = __builtin_amdgcn_rsqf(RSS2[row] * (1.0f / D) + EPS); const float* bp = BIAS2 + (size_t)(NB + srow) * (2 * FF) + ra0 + 4 * fq; \
                acc[0] = acc[0] * r + *(const f32x4*)bp; acc[1] = acc[1] * r + *(const f32x4*)(bp + 128); } \
            u32x2 w; w.x = cvt_pk_bf16(siluf_(acc[0][0]) * acc[1][0], siluf_(acc[0][1]) * acc[1][1]); w.y = cvt_pk_bf16(siluf_(acc[0][2]) * acc[1][2], siluf_(acc[0][3]) * acc[1][3]); \
            *(u32x2*)(HB + row * FF + j0 + 4 * fq) = w; } \
        pg8::Gemm g{XN, (WU), MP, 2 * FF, D}; pg8::StaticOrder S; S.init(MP, 2 * FF, G, bx); pg8::EpiUp<DEFN> E{ws}; \
        RUN_GEMM(pg8::EpiUp<DEFN>, g, S, E); } while (0)
#define SKINNY_RESID(BASES, GIDX, GS, NORMO, GAINP, SCIDX, RSSP) do { \
            const f32x4 gv = *(const f32x4*)(MOD + (size_t)(NB + srow) * NADA + (GIDX) * D + col) * (GS); \
            const f32x4 xv = *(const f32x4*)((BASES) + (size_t)srow * D + col) + gv * acc[0]; \
            *(f32x4*)(XS + (size_t)srow * D + col) = xv; \
            if (NORMO) { const f32x4 ca = *(const f32x4*)((GAINP) + col) * (*(const f32x4*)(MOD + (size_t)(NB + srow) * NADA + (SCIDX) * D + col) + 1.0f), xa = xv * ca; \
                u32x2 w; w.x = cvt_pk_bf16(xa[0], xa[1]); w.y = cvt_pk_bf16(xa[2], xa[3]); *(u32x2*)(XN + (size_t)(MP + srow) * D + col) = w; \
                float ss = (xv[0] * xv[0] + xv[1] * xv[1]) + (xv[2] * xv[2] + xv[3] * xv[3]); ss += __shfl_xor(ss, 16); ss += __shfl_xor(ss, 32); \
                if (fq == 0) atomicAdd((RSSP) + MP + srow, ss); } } while (0)
#define FFN_DOWN_PHASE(WD, BASEP, BASES, GIDX, NORMO, NIDX, GAINP, SCIDX, RSSP) do { \
        for (int it = vcu; it < D / 16; it += G) { \
            f32x4 acc[1]; acc[0] = (f32x4){0.f, 0.f, 0.f, 0.f}; \
            const int srow = 16 * wave + fr, col = 16 * it + 4 * fq; \
            const bf16_t* bp = (WD) + (size_t)(16 * it + fr) * FF + 8 * fq; \
            skinny_dot<1>(acc, HB + (size_t)(MP + srow) * FF + 8 * fq, bp, bp, FF / 32); \
            SKINNY_RESID(BASES, GIDX, 0.5f, NORMO, GAINP, SCIDX, RSSP); } \
        pg8::Gemm g{HB, (WD), MP, D, FF}; pg8::StaticOrder S; S.init(MP, D, G, bx); typedef pg8::EpiResid<NORMO, GIDX, 1, NIDX> EpiR; EpiR E{(BASEP), YP, ws}; \
        RUN_GEMM(EpiR, g, S, E); } while (0)

    if (IN(3)) { LANE_VARS(); FFN_UP_PHASE(W1U, false); if (BOTH(3)) GRID_BAR(); }
    if (IN(4)) { LANE_VARS(); KV_BEFORE(0); FFN_DOWN_PHASE(W1D, x_prompt, x_sample, 2, true, 1, norm_g + D, 4, RSS1); KV_AFTER(0); if (BOTH(4)) GRID_BAR(); }


    if (IN(6)) {
        LANE_VARS();
        for (int it = vcu; it < DIN / 16; it += G) {
            f32x4 acc[1]; acc[0] = (f32x4){0.f, 0.f, 0.f, 0.f};
            const int srow = 16 * wave + fr, col = 16 * it + 4 * fq;
            const bf16_t* bp = WIN + (size_t)(16 * it + fr) * D + 8 * fq;
            skinny_dot<1>(acc, XN + (size_t)(MP + srow) * D + 8 * fq, bp, bp, D / 32);
            acc[0] = acc[0] * __builtin_amdgcn_rsqf(RSS1[MP + srow] * (1.0f / D) + EPS) + *(const f32x4*)(BIAS1 + (size_t)(NB + srow) * DIN + col);
            *(f32x4*)(PROJS + (size_t)srow * DIN + col) = acc[0];
            if (col >= DATT && col < 3 * DATT) {
                const int isv = col >= 2 * DATT ? 1 : 0, cc = col - (isv ? 2 * DATT : DATT), g = cc >> 8, L = 128 << (2 * g);
                const size_t ob = (g == 0 ? O_KV0S : (g == 1 ? O_KV1S : O_KV2S)) + ((size_t)srow * L + (L - 1)) * 512 + isv * 256 + (cc & 255);
                *(f32x4*)(out + ob) = acc[0];
            }
        }
        pg8::Gemm g{XN, WIN, MP, DIN, D}; pg8::StaticOrder S; S.init(MP, DIN, G, bx); pg8::EpiProj E{ws, out};
        RUN_GEMM(pg8::EpiProj, g, S, E);
        if (BOTH(6)) GRID_BAR();
    }

    if (IN(7)) {
        LANE_VARS();
        attn_prompt_phase(lds + RING_OFF, QKV, AG, LSE, vcu, G, tidv, wave, lane);
        gmlp_phase(lds + RING_OFF, VBB, UB, WSP, b_sp, v_ln_g, v_ln_b, AG, out, vcu, G, wave, lane);
        for (int u = vcu; u < DB; u += G) sample_unit(lds, PROJS, cache0, cache1, cache2, w_sp, b_sp, v_ln_g, v_ln_b, AG, out, u, tidv, wave, lane);
        if (BOTH(7)) GRID_BAR();
    }

    if (IN(8)) {
        LANE_VARS();
        for (size_t i = gt; i < (size_t)MP * 96; i += NT) {
            const size_t t = i / 96; const int ch = (int)(i - t * 96), head = ch >> 3, hh = head & 3, g = head >> 2;
            const float l0 = LSE[t * 12 + hh], l1 = LSE[t * 12 + 4 + hh], l2 = LSE[t * 12 + 8 + hh], m = fmaxf(l0, fmaxf(l1, l2));
            const float e0 = __expf(l0 - m), e1 = __expf(l1 - m), e2 = __expf(l2 - m);
            const float w = (g == 0 ? e0 : (g == 1 ? e1 : e2)) / (e0 + e1 + e2);
            u32x4* p = (u32x4*)(AG + t * KAG + ch * 8); const u32x4 v = *p;
            u32x4 o; o.x = cvt_pk_bf16(bflo(v.x) * w, bfhi(v.x) * w); o.y = cvt_pk_bf16(bflo(v.y) * w, bfhi(v.y) * w); o.z = cvt_pk_bf16(bflo(v.z) * w, bfhi(v.z) * w); o.w = cvt_pk_bf16(bflo(v.w) * w, bfhi(v.w) * w);
            *p = o;
        }
        if (BOTH(8)) GRID_BAR();
    }

    if (IN(9)) {
        LANE_VARS();
        KV_BEFORE(1);
        for (int it = vcu; it < D / 16; it += G) {
            f32x4 a0[1], a1[1]; a0[0] = (f32x4){0.f, 0.f, 0.f, 0.f}; a1[0] = a0[0];
            const int srow = 16 * wave + fr, col = 16 * it + 4 * fq;
            const bf16_t* bp = WAB + (size_t)(16 * it + fr) * KAG + 8 * fq; const bf16_t* ap = AG + (size_t)(MP + srow) * KAG + 8 * fq;
            skinny_dot<1>(a0, ap, bp, bp, DATT / 32);
            skinny_dot<1>(a1, ap + DATT, bp + DATT, bp + DATT, DG / 32);
            const f32x4 ga = *(const f32x4*)(PROJS + (size_t)srow * DIN + 3328 + col), gb = *(const f32x4*)(PROJS + (size_t)srow * DIN + 4352 + col);
            u32x2 w; w.x = cvt_pk_bf16(sigmoidf_(ga[0]) * a0[0][0] + sigmoidf_(gb[0]) * a1[0][0], sigmoidf_(ga[1]) * a0[0][1] + sigmoidf_(gb[1]) * a1[0][1]);
            w.y = cvt_pk_bf16(sigmoidf_(ga[2]) * a0[0][2] + sigmoidf_(gb[2]) * a1[0][2], sigmoidf_(ga[3]) * a0[0][3] + sigmoidf_(gb[3]) * a1[0][3]);
            *(u32x2*)(MG + (size_t)(MP + srow) * D + col) = w;
        }
        pg8::Gemm g{AG, WAB, MP, D, KAG}; pg8::StaticOrder S; S.init(MP, D, G, bx); pg8::EpiMerge E{ws};
        RUN_GEMM(pg8::EpiMerge, g, S, E);
        KV_AFTER(1);
        if (BOTH(9)) GRID_BAR();
    }

    if (IN(10)) {
        LANE_VARS();
        KV_BEFORE(2);
        for (int it = vcu; it < D / 16; it += G) {
            f32x4 acc[1]; acc[0] = (f32x4){0.f, 0.f, 0.f, 0.f};
            const int srow = 16 * wave + fr, col = 16 * it + 4 * fq;
            const bf16_t* bp = WO + (size_t)(16 * it + fr) * D + 8 * fq;
            skinny_dot<1>(acc, MG + (size_t)(MP + srow) * D + 8 * fq, bp, bp, D / 32);
            SKINNY_RESID(XS, 5, 1.0f, true, norm_g + 2 * D, 7, RSS2);
        }
        pg8::Gemm g{MG, WO, MP, D, D}; pg8::StaticOrder S; S.init(MP, D, G, bx); typedef pg8::EpiResid<true, 5, 2, 2> EpiR; EpiR E{YP, YP, ws};
        RUN_GEMM(EpiR, g, S, E);
        KV_AFTER(2);
        if (BOTH(10)) GRID_BAR();
    }


    if (IN(12)) { LANE_VARS(); FFN_UP_PHASE(W2U, true); if (BOTH(12)) GRID_BAR(); }
    if (IN(13)) { LANE_VARS(); KV_BEFORE(3); FFN_DOWN_PHASE(W2D, YP, XS, 8, false, 1, norm_g, 0, RSS1); KV_AFTER(3); if (BOTH(13)) GRID_BAR(); }

    if (IN(14)) { LANE_VARS(); final_norm_rows(YP, XS, out + O_YS, final_g, gw, NGW, lane); }
#undef IN
#undef BOTH
}

extern "C" void kernel_launch(void* const* d_in, const int* in_sizes, int n_in, void* d_out, int out_size, void* d_ws, size_t ws_size, hipStream_t stream) {
    static int grid = 0;
    if (grid == 0) {
        if (n_in != 23 || in_sizes[0] != MP * D || (size_t)out_size != O_END || ws_size < WS_END) {
            fprintf(stderr, "kernel_launch: unexpected shapes: n_in %d, in0 %d, out %d, ws %zu (need %zu); nothing launched\n", n_in, n_in > 0 ? in_sizes[0] : -1, out_size, ws_size, (size_t)WS_END); grid = -1; return; }
        int dev = 0, cus = 0, per_cu = 0;
        if (hipGetDevice(&dev) != hipSuccess || hipDeviceGetAttribute(&cus, hipDeviceAttributeMultiprocessorCount, dev) != hipSuccess) { fprintf(stderr, "kernel_launch: device query failed\n"); grid = -1; return; }
        if (hipFuncSetAttribute((const void*)fwd_kernel, hipFuncAttributeMaxDynamicSharedMemorySize, LDS_BYTES) != hipSuccess) { fprintf(stderr, "kernel_launch: hipFuncSetAttribute failed\n"); grid = -1; return; }
        if (hipOccupancyMaxActiveBlocksPerMultiprocessor(&per_cu, (const void*)fwd_kernel, NWAVES * 64, LDS_BYTES) != hipSuccess || per_cu < 1)
            fprintf(stderr, "kernel_launch: note: occupancy query reports %d workgroups per CU\n", per_cu);
        (void)hipGetLastError();
        grid = cus;
    }
    if (grid < 0) return;
    if (hipMemsetAsync((char*)d_ws + WS_CTL, 0, CTL_ZERO_BYTES, stream) != hipSuccess) { fprintf(stderr, "kernel_launch: hipMemsetAsync failed\n"); return; }
    Args a{};
    for (int i = 0; i < 23; ++i) a.in[i] = (const float*)d_in[i];
    a.out = (float*)d_out; a.ws = (unsigned char*)d_ws;
    for (int li = 0; li < N_LAUNCHES; ++li) {
        a.ph_lo = SEGS[2 * li]; a.ph_hi = SEGS[2 * li + 1]; a.li = li; a.pad = 0;
        hipLaunchKernelGGL(fwd_kernel, dim3(grid), dim3(NWAVES * 64), LDS_BYTES, stream, a);
        const hipError_t le = hipPeekAtLastError();
        if (le != hipSuccess) { fprintf(stderr, "kernel_launch: launch %d failed: %s\n", li, hipGetErrorName(le)); break; }
    }
}
```
